# Optimizing an MI355X kernel written in HIP

```python
import math
import jax
import jax.numpy as jnp
from jax import lax
import numpy as np


D_MODEL = 1024
BATCH = 4
SEQ = 8192
DEPTH = 2

GRID_W = 64
HEAD_DIM = 64
Q_BLOCK = 128
NA_HEADS = 6
NA_ROWS = 8
NA_COLS = 16
GQA_HEADS = 6
GQA_KV_HEADS = 2
ROPE_THETA = 10000.0
DIL_GROUPS = ((128, 1), (512, 4), (2048, 16))
DIL_HEADS_PER_GROUP = 2
DIL_HEADS = DIL_HEADS_PER_GROUP * len(DIL_GROUPS)
DIFF_HEADS = 4
DIFF_V_DIM = 2 * HEAD_DIM
N_BRANCHES = 4
T5_BUCKETS = 32
T5_MAX_DISTANCE = 1024
T5_HEADS = DIL_HEADS + DIFF_HEADS
N_EXPERTS = 16
EC_CAPACITY = 2
EXPERT_FF = 2048
PLE_DIM = 256
DEEPNORM_ALPHA = (2 * DEPTH) ** 0.25
DEEPNORM_BETA = (8 * DEPTH) ** -0.25
NEG_INF = -1e30

NA_W = NA_HEADS * HEAD_DIM
GQA_Q_W = GQA_HEADS * HEAD_DIM
GQA_KV_W = GQA_KV_HEADS * HEAD_DIM
DIL_W = DIL_HEADS * HEAD_DIM
DIL_OUT_W = DIL_HEADS_PER_GROUP * HEAD_DIM
DIFF_QK_W = DIFF_HEADS * 2 * HEAD_DIM
DIFF_V_W = DIFF_HEADS * DIFF_V_DIM
IN_SPLITS = (NA_W, NA_W, NA_W, GQA_Q_W, GQA_KV_W, GQA_KV_W, DIL_W, DIL_W, DIL_W,
             DIFF_QK_W, DIFF_QK_W, DIFF_V_W, N_BRANCHES * D_MODEL)
IN_WIDTH = sum(IN_SPLITS)

kernel_name = 'hybrid_gated_mixers_ec_moe_encoder'


def layer_norm(x, g, b, eps=1e-5):
    xf = x.astype(jnp.float32)
    mu = jnp.mean(xf, axis=-1, keepdims=True)
    xc = xf - mu
    var = jnp.mean(xc * xc, axis=-1, keepdims=True)
    return (xc * lax.rsqrt(var + eps) * g + b).astype(x.dtype)


def rms_norm(x, g, eps=1e-6):
    xf = x.astype(jnp.float32)
    y = xf * lax.rsqrt(jnp.mean(xf * xf, axis=-1, keepdims=True) + eps)
    return (y * g).astype(x.dtype)


def t5_bucket(rel):
    half = T5_BUCKETS // 2
    exact = half // 2
    n = jnp.abs(rel)
    nf = jnp.maximum(n, 1).astype(jnp.float32)
    large = exact + (jnp.log(nf / exact) / math.log(T5_MAX_DISTANCE / exact) * (half - exact)).astype(jnp.int32)
    large = jnp.minimum(large, half - 1)
    return jnp.where(rel > 0, half, 0) + jnp.where(n < exact, n, large)


def _to_blocks(t):
    b, s = t.shape[:2]
    return jnp.swapaxes(t.reshape(b, s // Q_BLOCK, Q_BLOCK, *t.shape[2:]), 0, 1)


def _from_blocks(t):
    n, b, blk = t.shape[:3]
    return jnp.swapaxes(t, 0, 1).reshape(b, n * blk, *t.shape[3:])


def neighborhood_attention(q, k, v, rpb):
    B, S, H, dh = q.shape
    rows = S // GRID_W
    wr = min(NA_ROWS, rows)
    scale = dh ** -0.5
    qg = q.reshape(B, rows, GRID_W, H, dh)
    kg = k.reshape(B, rows, GRID_W, H, dh)
    vg = v.reshape(B, rows, GRID_W, H, dh)
    col = jnp.arange(GRID_W)
    cidx = jnp.clip(col - NA_COLS // 2, 0, GRID_W - NA_COLS)[:, None] + jnp.arange(NA_COLS)[None, :]
    dc = cidx - col[:, None] + (NA_COLS - 1)

    def row_fn(r):
        rs = jnp.clip(r - wr // 2, 0, rows - wr)
        kr = lax.dynamic_slice_in_dim(kg, rs, wr, axis=1)[:, :, cidx]
        vr = lax.dynamic_slice_in_dim(vg, rs, wr, axis=1)[:, :, cidx]
        qr = lax.dynamic_index_in_dim(qg, r, axis=1, keepdims=False)
        dr = rs + jnp.arange(wr) - r + (NA_ROWS - 1)
        bias = rpb[:, dr[None, :, None], dc[:, None, :]].astype(jnp.float32)
        logits = jnp.einsum('bchd,bicjhd->bhcij', qr, kr).astype(jnp.float32) * scale + bias[None]
        pr = jax.nn.softmax(logits.reshape(B, H, GRID_W, wr * NA_COLS), axis=-1)
        pr = pr.reshape(B, H, GRID_W, wr, NA_COLS).astype(v.dtype)
        return jnp.einsum('bhcij,bicjhd->bchd', pr, vr)

    out = lax.map(row_fn, jnp.arange(rows))
    return jnp.swapaxes(out, 0, 1).reshape(B, S, H * dh)


def axial_rope(x, row, col):
    half = HEAD_DIM // 2
    quarter = half // 2
    freqs = ROPE_THETA ** (-jnp.arange(quarter, dtype=jnp.float32) / quarter)

    def rot(xh, pos):
        ang = pos[:, None] * freqs[None, :]
        c = jnp.cos(ang)[None, :, None, :].astype(x.dtype)
        s = jnp.sin(ang)[None, :, None, :].astype(x.dtype)
        x1, x2 = xh[..., :quarter], xh[..., quarter:]
        return jnp.concatenate([x1 * c - x2 * s, x2 * c + x1 * s], axis=-1)

    return jnp.concatenate([rot(x[..., :half], row), rot(x[..., half:], col)], axis=-1)


def gqa_attention(q, k, v):
    B, S, _, dh = q.shape
    rep = GQA_HEADS // GQA_KV_HEADS
    scale = dh ** -0.5
    qb = _to_blocks(q.reshape(B, S, GQA_KV_HEADS, rep, dh))

    def blk(qi):
        logits = jnp.einsum('bqgrd,bkgd->bgrqk', qi, k).astype(jnp.float32) * scale
        pr = jax.nn.softmax(logits, axis=-1).astype(v.dtype)
        return jnp.einsum('bgrqk,bkgd->bqgrd', pr, v)

    return _from_blocks(lax.map(blk, qb)).reshape(B, S, GQA_HEADS * dh)


def dilated_attention(q, k, v, t5_table):
    B, S, _, dh = q.shape
    hpg = DIL_HEADS_PER_GROUP
    scale = dh ** -0.5
    groups = []
    for g, (w, d) in enumerate(DIL_GROUPS):
        n = w // (2 * d)
        off = jnp.arange(-n, n + 1) * d
        hs = slice(g * hpg, (g + 1) * hpg)
        bias = t5_table[t5_bucket(off), hs].T.astype(jnp.float32)
        groups.append((off, k[:, :, hs], v[:, :, hs], bias))

    def blk(args):
        qi, bi = args
        qpos = bi * Q_BLOCK + jnp.arange(Q_BLOCK)
        outs, lses = [], []
        for g, (off, kg, vg, bias) in enumerate(groups):
            kpos = qpos[:, None] + off[None, :]
            valid = (kpos >= 0) & (kpos < S)
            kidx = jnp.clip(kpos, 0, S - 1)
            kk = kg[:, kidx]
            vv = vg[:, kidx]
            qg = qi[:, :, g * hpg:(g + 1) * hpg]
            logits = jnp.einsum('bqhd,bqjhd->bhqj', qg, kk).astype(jnp.float32) * scale + bias[None, :, None, :]
            logits = jnp.where(valid[None, None], logits, NEG_INF)
            lse = jax.nn.logsumexp(logits, axis=-1)
            pr = jnp.exp(logits - lse[..., None]).astype(v.dtype)
            outs.append(jnp.einsum('bhqj,bqjhd->bqhd', pr, vv))
            lses.append(lse)
        wts = jax.nn.softmax(jnp.stack(lses), axis=0)
        wts = jnp.swapaxes(wts, 2, 3)[..., None].astype(v.dtype)
        return jnp.sum(wts * jnp.stack(outs), axis=0)

    out = lax.map(blk, (_to_blocks(q), jnp.arange(S // Q_BLOCK)))
    return _from_blocks(out).reshape(B, S, DIL_OUT_W)


def diff_attention(q, k, v, lam_params, gain, t5_table, lam_init):
    B, S, H = q.shape[:3]
    lp = lam_params.astype(jnp.float32)
    lam = jnp.exp(jnp.sum(lp[0] * lp[1])) - jnp.exp(jnp.sum(lp[2] * lp[3])) + lam_init
    k1, k2 = k[..., 0, :], k[..., 1, :]
    scale = HEAD_DIM ** -0.5
    kpos = jnp.arange(S)

    def blk(args):
        qi, bi = args
        qpos = bi * Q_BLOCK + jnp.arange(Q_BLOCK)
        bias = jnp.moveaxis(t5_table[t5_bucket(kpos[None, :] - qpos[:, None])], -1, 0).astype(jnp.float32)
        l1 = jnp.einsum('bqhd,bkhd->bhqk', qi[..., 0, :], k1).astype(jnp.float32) * scale + bias[None]
        l2 = jnp.einsum('bqhd,bkhd->bhqk', qi[..., 1, :], k2).astype(jnp.float32) * scale + bias[None]
        attn = jax.nn.softmax(l1, axis=-1) - lam * jax.nn.softmax(l2, axis=-1)
        return jnp.einsum('bhqk,bkhe->bqhe', attn.astype(v.dtype), v)

    out = _from_blocks(lax.map(blk, (_to_blocks(q), jnp.arange(S // Q_BLOCK))))
    out = rms_norm(out, gain) * (1.0 - lam_init)
    return out.reshape(B, S, H * DIFF_V_DIM)


def token_mixer(x, w_in, w_na, w_gqa, w_dil, w_diff, w_o, rpb, qk_gain, lam_params, diff_gain, t5_bias, lam_init):
    B, S, D = x.shape
    h = x @ w_in
    offs = np.cumsum(IN_SPLITS)[:-1].tolist()
    qa, ka, va, qb, kb, vb, qc, kc, vc, qd, kd, vd, gates = jnp.split(h, offs, axis=-1)

    def heads(t, n):
        return t.reshape(B, S, n, HEAD_DIM)

    ya = neighborhood_attention(heads(qa, NA_HEADS), heads(ka, NA_HEADS), heads(va, NA_HEADS), rpb)
    t = jnp.arange(S)
    row = (t // GRID_W).astype(jnp.float32)
    col = (t % GRID_W).astype(jnp.float32)
    qn = axial_rope(rms_norm(heads(qb, GQA_HEADS), qk_gain[0]), row, col)
    kn = axial_rope(rms_norm(heads(kb, GQA_KV_HEADS), qk_gain[1]), row, col)
    yb = gqa_attention(qn, kn, heads(vb, GQA_KV_HEADS))
    yc = dilated_attention(heads(qc, DIL_HEADS), heads(kc, DIL_HEADS), heads(vc, DIL_HEADS), t5_bias[:, :DIL_HEADS])
    yd = diff_attention(qd.reshape(B, S, DIFF_HEADS, 2, HEAD_DIM), kd.reshape(B, S, DIFF_HEADS, 2, HEAD_DIM),
                        vd.reshape(B, S, DIFF_HEADS, DIFF_V_DIM), lam_params, diff_gain,
                        t5_bias[:, DIL_HEADS:], lam_init)
    g = jax.nn.sigmoid(gates.reshape(B, S, N_BRANCHES, D))
    merged = (g[:, :, 0] * (ya @ w_na) + g[:, :, 1] * (yb @ w_gqa)
              + g[:, :, 2] * (yc @ w_dil) + g[:, :, 3] * (yd @ w_diff))
    return merged @ w_o


def expert_choice_ffn(x, w_router, w_gate, w_up, w_down):
    B, S, D = x.shape
    cap = EC_CAPACITY * S // N_EXPERTS
    aff = jax.nn.softmax((x @ w_router).astype(jnp.float32), axis=-1)
    gate, idx = lax.top_k(jnp.swapaxes(aff, 1, 2), cap)
    bidx = jnp.arange(B)[:, None, None]
    xin = x[bidx, idx]
    hid = jax.nn.silu(jnp.einsum('becd,edf->becf', xin, w_gate)) * jnp.einsum('becd,edf->becf', xin, w_up)
    yo = jnp.einsum('becf,efd->becd', hid, w_down) * gate[..., None].astype(x.dtype)
    flat = (bidx * S + idx).reshape(-1)
    y = jnp.zeros((B * S, D), yo.dtype).at[flat].add(yo.reshape(-1, D))
    return y.reshape(B, S, D)


def setup_inputs(seed: int = 0) -> dict:
    key = jax.random.key(seed)
    ks = jax.random.split(key, 21)

    def nrm(k, shape, scale):
        return jax.random.normal(k, shape, jnp.float32) * scale

    beta = DEEPNORM_BETA
    D = D_MODEL
    return {
        'x': nrm(ks[0], (BATCH, SEQ, D), 1.0),
        'p': nrm(ks[1], (DEPTH, BATCH, SEQ, PLE_DIM), 1.0),
        'w_in': nrm(ks[2], (DEPTH, D, IN_WIDTH), D ** -0.5),
        'w_branch_na': nrm(ks[3], (DEPTH, NA_W, D), NA_W ** -0.5),
        'w_branch_gqa': nrm(ks[4], (DEPTH, GQA_Q_W, D), GQA_Q_W ** -0.5),
        'w_branch_dil': nrm(ks[5], (DEPTH, DIL_OUT_W, D), DIL_OUT_W ** -0.5),
        'w_branch_diff': nrm(ks[6], (DEPTH, DIFF_V_W, D), DIFF_V_W ** -0.5),
        'w_out': nrm(ks[7], (DEPTH, D, D), beta * D ** -0.5),
        'na_rel_bias': nrm(ks[8], (DEPTH, NA_HEADS, 2 * NA_ROWS - 1, 2 * NA_COLS - 1), 0.1),
        'qk_norm_gain': 1.0 + nrm(ks[9], (DEPTH, 2, HEAD_DIM), 0.02),
        'diff_lambda': nrm(ks[10], (DEPTH, 4, HEAD_DIM), 0.1),
        'diff_norm_gain': 1.0 + nrm(ks[11], (DEPTH, DIFF_V_DIM), 0.02),
        't5_rel_bias': nrm(ks[12], (T5_BUCKETS, T5_HEADS), 0.1),
        'w_router': nrm(ks[13], (DEPTH, D, N_EXPERTS), D ** -0.5),
        'w_expert_gate': nrm(ks[14], (DEPTH, N_EXPERTS, D, EXPERT_FF), D ** -0.5),
        'w_expert_up': nrm(ks[15], (DEPTH, N_EXPERTS, D, EXPERT_FF), D ** -0.5),
        'w_expert_down': nrm(ks[16], (DEPTH, N_EXPERTS, EXPERT_FF, D), beta * EXPERT_FF ** -0.5),
        'w_ple_proj': nrm(ks[17], (DEPTH, PLE_DIM, D), beta * PLE_DIM ** -0.5),
        'w_ple_gate': nrm(ks[18], (DEPTH, D, D), D ** -0.5),
        'ln_gain': 1.0 + nrm(ks[19], (DEPTH, 3, D), 0.02),
        'ln_bias': nrm(ks[20], (DEPTH, 3, D), 0.02),
    }


def reference(x, p, w_in, w_branch_na, w_branch_gqa, w_branch_dil, w_branch_diff, w_out, na_rel_bias,
              qk_norm_gain, diff_lambda, diff_norm_gain, t5_rel_bias, w_router, w_expert_gate, w_expert_up,
              w_expert_down, w_ple_proj, w_ple_gate, ln_gain, ln_bias):
    for i in range(DEPTH):
        lam_init = 0.8 - 0.6 * math.exp(-0.3 * i)
        y = token_mixer(x, w_in[i], w_branch_na[i], w_branch_gqa[i], w_branch_dil[i], w_branch_diff[i],
                        w_out[i], na_rel_bias[i], qk_norm_gain[i], diff_lambda[i], diff_norm_gain[i],
                        t5_rel_bias, lam_init)
        x = layer_norm(DEEPNORM_ALPHA * x + y, ln_gain[i, 0], ln_bias[i, 0])
        y = expert_choice_ffn(x, w_router[i], w_expert_gate[i], w_expert_up[i], w_expert_down[i])
        x = layer_norm(DEEPNORM_ALPHA * x + y, ln_gain[i, 1], ln_bias[i, 1])
        e = (p[i] @ w_ple_proj[i]) * jax.nn.sigmoid(x @ w_ple_gate[i])
        x = layer_norm(DEEPNORM_ALPHA * x + e, ln_gain[i, 2], ln_bias[i, 2])
    return x
```

```cpp
#include <hip/hip_runtime.h>
#include <cstdio>
#include <cstdint>

#define LAS __attribute__((address_space(3)))
#define GAS __attribute__((address_space(1)))
typedef unsigned short bf16_t;
typedef short bf16x8 __attribute__((ext_vector_type(8)));
typedef short s16x4 __attribute__((ext_vector_type(4)));
typedef float f32x2 __attribute__((ext_vector_type(2)));
typedef float f32x4 __attribute__((ext_vector_type(4)));
typedef float f32x16 __attribute__((ext_vector_type(16)));
typedef unsigned u32x2 __attribute__((ext_vector_type(2)));
typedef unsigned u32x4 __attribute__((ext_vector_type(4)));

constexpr int DM = 1024, NB = 4, SEQ = 8192, MTOK = NB * SEQ, DEPTH = 2;
constexpr int INW = 8576, HW = 4608, NGATE = 4096;
constexpr int C_QA = 0, C_KA = 384, C_VA = 768, C_QB = 1152, C_KB = 1536, C_VB = 1664, C_QC = 1792, C_KC = 2176, C_VC = 2560, C_QD = 2944, C_KD = 3456, C_VD = 3968, C_HEND = 4480;
constexpr int NEXP = 16, CAP = 1024, FF = 2048, PLE = 256;
constexpr float LOG2E = 1.4426950408889634f;
constexpr float QSCALE = 0.125f * LOG2E;
constexpr float ALPHA = 1.4142135623730951f;
constexpr float LN_EPS = 1e-5f;

constexpr size_t MiB = 1u << 20;
constexpr size_t WS_CTL = 0, CTL_ZERO_BYTES = 256 * 1024;
constexpr size_t WS_WIN = 1 * MiB;
constexpr size_t WS_WG = 10 * MiB;
constexpr size_t WS_WNA = 18 * MiB;
constexpr size_t WS_WGQA = WS_WNA + 768 * 1024;
constexpr size_t WS_WDIL = WS_WGQA + 768 * 1024;
constexpr size_t WS_WDIFF = 20 * MiB;
constexpr size_t WS_WO = 21 * MiB;
constexpr size_t WS_WPG = 23 * MiB;
constexpr size_t WS_WPP = 25 * MiB;
constexpr size_t WS_WGU = 27 * MiB;
constexpr size_t WS_WD = 155 * MiB;
constexpr size_t WS_Z1 = 219 * MiB;
constexpr size_t WS_Z2 = 347 * MiB;
constexpr size_t WS_S = WS_Z1;
static_assert(WS_WIN + (size_t)HW * DM * 2 == WS_WG && WS_Z1 + 128 * MiB == WS_Z2, "contiguity");
constexpr size_t WS_XB = 475 * MiB;
constexpr size_t WS_PB = 539 * MiB;
constexpr size_t WS_AFF = 555 * MiB;
constexpr size_t WS_SLOT = 557 * MiB;
constexpr size_t WS_IDX = 559 * MiB;
constexpr size_t WS_GATEV = WS_IDX + 256 * 1024;
constexpr size_t WS_R = 560 * MiB;
constexpr size_t WS_H = WS_R;
constexpr size_t WS_YA = WS_R + 288 * MiB;
constexpr size_t WS_YB = WS_YA + 24 * MiB;
constexpr size_t WS_YC = WS_YB + 24 * MiB;
constexpr size_t WS_YD = WS_YC + 16 * MiB;
constexpr size_t WS_MERGED = WS_YD + 32 * MiB;
constexpr size_t WS_END = WS_MERGED + 64 * MiB;
constexpr size_t WS_XIN = WS_R;
constexpr size_t WS_HID = WS_R + 128 * MiB;
static_assert(WS_HID + 256 * MiB <= WS_MERGED, "ffn overlay");
constexpr int CW_BAR = 1024;

constexpr int LDS_BYTES = 147456;
constexpr int MISC_OFF = 131072 + 320;

typedef __bf16 bf16x2_t __attribute__((ext_vector_type(2)));
__device__ __forceinline__ unsigned cvt_pk_bf16(float lo, float hi) { f32x2 v = {lo, hi}; bf16x2_t b = __builtin_convertvector(v, bf16x2_t); return __builtin_bit_cast(unsigned, b); }
__device__ __forceinline__ float bf_lo(unsigned w) { return __uint_as_float(w << 16); }
__device__ __forceinline__ float bf_hi(unsigned w) { return __uint_as_float(w & 0xffff0000u); }
__device__ __forceinline__ float fast_sigmoid(float x) { return __builtin_amdgcn_rcpf(1.0f + __builtin_amdgcn_exp2f(-x * LOG2E)); }
__device__ __forceinline__ float wave_sum(float v) {
#pragma unroll
    for (int o = 1; o < 64; o <<= 1) v += __shfl_xor(v, o);
    return v;
}
#define LDS_WAIT() asm volatile("s_waitcnt lgkmcnt(0)" ::: "memory")
#define VM_WAIT() asm volatile("s_waitcnt vmcnt(0)" ::: "memory")

#define XB_TMO      128
#define XB_XCNT(j)  (256  + 64 * (j))
#define XB_XSUB(j)  (1280 + 64 * (j))
#define XB_XGEN(j)  (2304 + 64 * (j))
#define XB_TOP      3328
#define XB_TOPGEN   3392
#define XCD_BAR_WORDS 3456
#define XB_SPIN_CAP (1u << 22)
__device__ __forceinline__ unsigned xb_ld(unsigned* p)              { return __hip_atomic_load(p, __ATOMIC_RELAXED, __HIP_MEMORY_SCOPE_AGENT); }
__device__ __forceinline__ unsigned xb_add(unsigned* p, unsigned v) { return __hip_atomic_fetch_add(p, v, __ATOMIC_RELAXED, __HIP_MEMORY_SCOPE_AGENT); }
__device__ __forceinline__ unsigned xb_xcc_id() { return (unsigned)__builtin_amdgcn_s_getreg((3 << 11) | 20) & 0xFu; }
#define XB_SPIN(cond, bar) do { unsigned _sp = 0; while (cond) { __builtin_amdgcn_s_sleep(1); \
    if ((++_sp & 255u) == 0u) { if (xb_ld(&(bar)[XB_TMO])) break; if (_sp > XB_SPIN_CAP) { atomicAdd(&(bar)[XB_TMO], 1u); break; } } } } while (0)
struct XcdBarrier { unsigned* bar; unsigned x; volatile LAS unsigned* st; };
__device__ __forceinline__ XcdBarrier xcd_barrier_post(unsigned* bar, volatile LAS unsigned* st) {
    XcdBarrier b; b.bar = bar; b.x = xb_xcc_id(); b.st = st;
    if (threadIdx.x == 0) (void)xb_add(&bar[XB_XCNT(b.x)], 1u);
    return b;
}
__device__ __forceinline__ void xcd_barrier_complete(unsigned* bar, unsigned x, unsigned& nloc, unsigned& nx) {
    const unsigned G = gridDim.x * gridDim.y * gridDim.z;
    unsigned sum, cnt, mine, sp = 0u;
    for (;;) {
        sum = 0u; cnt = 0u; mine = 0u;
#pragma unroll
        for (unsigned j = 0; j < 16; ++j) { const unsigned c = xb_ld(&bar[XB_XCNT(j)]); sum += c; cnt += (c > 0u) ? 1u : 0u; mine = (j == x) ? c : mine; }
        if (sum == G) break;
        __builtin_amdgcn_s_sleep(1);
        if ((++sp & 255u) == 0u) { if (xb_ld(&bar[XB_TMO])) break; if (sp > XB_SPIN_CAP) { atomicAdd(&bar[XB_TMO], 1u); break; } }
    }
    nloc = mine > 0u ? mine : 1u; nx = cnt > 0u ? cnt : 1u;
}
__device__ __forceinline__ void xcd_barrier(const XcdBarrier& b) {
    asm volatile("s_waitcnt vmcnt(0)" ::: "memory");
    __syncthreads();
    if (threadIdx.x == 0) {
        unsigned* bar = b.bar;
        __builtin_amdgcn_s_waitcnt(0);
        unsigned nloc = b.st[0], nx = b.st[1];
        if (nloc == 0u) { xcd_barrier_complete(bar, b.x, nloc, nx); b.st[0] = nloc; b.st[1] = nx; }
        const unsigned old = xb_add(&bar[XB_XSUB(b.x)], 1u);
        const unsigned gen = old / nloc;
        if (old + 1u == (gen + 1u) * nloc) {
            __builtin_amdgcn_fence(__ATOMIC_RELEASE, "agent");
            asm volatile("s_waitcnt vmcnt(0)" ::: "memory");
            const unsigned og = xb_add(&bar[XB_TOP], 1u);
            const unsigned tg = og / nx;
            if (og + 1u == (tg + 1u) * nx) xb_add(&bar[XB_TOPGEN], 1u);
            else XB_SPIN(xb_ld(&bar[XB_TOPGEN]) == tg, bar);
            __builtin_amdgcn_fence(__ATOMIC_ACQUIRE, "agent");
            xb_add(&bar[XB_XGEN(b.x)], 1u);
            asm volatile("s_waitcnt vmcnt(0)" ::: "memory");
        } else {
            XB_SPIN(xb_ld(&bar[XB_XGEN(b.x)]) == gen, bar);
            __builtin_amdgcn_fence(__ATOMIC_ACQUIRE, "agent");
            asm volatile("s_waitcnt vmcnt(0)" ::: "memory");
        }
    }
    __syncthreads();
}

namespace pg8 {
constexpr int BM = 256, BK = 64, HALF = 128, HTB = HALF * BK * 2, STAGE_BYTES = 8 * HTB, NXCD = 8, WGM = 8;
__host__ __device__ __forceinline__ int lds_byte(int r, int c) { const int st = (r >> 4) * 2 + (c >> 5), rr = r & 15, cc = c & 31, ob = rr * 64 + cc * 2; return st * 1024 + (ob ^ (((ob >> 9) & 1) << 5)); }
__host__ __device__ __forceinline__ void stage_rc(int b, int& R, int& C) { const int st = b / 1024, sb = b % 1024, swz = sb ^ (((sb >> 9) & 1) << 5); R = (st >> 1) * 16 + swz / 64; C = (st & 1) * 32 + (swz % 64) / 2; }
__host__ __device__ __forceinline__ int perm32(int rho) { const int n = rho >> 4, i = rho & 15; return 8 * (i >> 2) + 4 * n + (i & 3); }

struct Unit { const char* A; const char* B; int K2; int nt; int pm, pn, tag; };

__device__ __forceinline__ void tile_map(int L, int nM, int nN, int& pm, int& pn) {
    const int nwg = nM * nN; int wgid = L;
    { const int q = nwg / NXCD, r = nwg % NXCD, xcd = wgid % NXCD, off = wgid / NXCD; wgid = (xcd < r ? xcd * (q + 1) : r * (q + 1) + (xcd - r) * q) + off; }
    const int nig = WGM * nN, gid = wgid / nig, fm = gid * WGM, gsz = (nM - fm) < WGM ? (nM - fm) : WGM;
    pm = fm + ((wgid % nig) % gsz); pn = (wgid % nig) / gsz;
}

template <class Epi, class Sched>
__device__ __forceinline__ void gemm_phase(LAS unsigned char* lds, const Sched& S, const Epi& E, const int tid) {
    const int wid = __builtin_amdgcn_readfirstlane(tid >> 6), lane = tid & 63, wr = wid >> 2, wc = wid & 3, fr = lane & 15, fq = lane >> 4;
    int R0, C0; stage_rc(tid * 16, R0, C0);
    const int Rb0 = (R0 & ~31) + perm32(R0 & 31);
    const int Rbp = 2 * (R0 & ~31) + perm32(R0 & 31);
    const unsigned C02 = (unsigned)C0 * 2u;
    const size_t kstep = (size_t)(BK * 2);
    const unsigned ldsw = (unsigned)wid * 1024u;
    const int aoff = lds_byte(wr * 64 + fr, fq * 8), boff = lds_byte(wc * 32 + fr, fq * 8);
#define PG8_SA(b, h) (((b) * 2 + (h)) * HTB)
#define PG8_SB(b, h) ((4 + (b) * 2 + (h)) * HTB)
#define PG8_STAGE(bufoff, gbase, K2_, R_) do { _Pragma("unroll") for (int _i = 0; _i < 2; ++_i) \
        __builtin_amdgcn_global_load_lds((const unsigned*)((const char*)(gbase) + (unsigned)(((R_) + 64 * _i) * (K2_)) + C02), (LAS unsigned*)(lds + (bufoff) + ldsw + _i * 8192), 16, 0, 0); } while (0)
#define PG8_STAGE_B(bufoff, gb, h_, hs_, K2_) do { if constexpr (BP) { _Pragma("unroll") for (int _i = 0; _i < 2; ++_i) \
        __builtin_amdgcn_global_load_lds((const unsigned*)((const char*)(gb) + (size_t)(32 * (h_)) * (K2_) + (unsigned)((Rbp + 128 * _i) * (K2_)) + C02), (LAS unsigned*)(lds + (bufoff) + ldsw + _i * 8192), 16, 0, 0); } \
        else PG8_STAGE(bufoff, (const char*)(gb) + (h_) * (hs_), K2_, Rb0); } while (0)
#define PG8_STAGE_A(bufoff, gk, h_, hs_, K2_, AR_) do { if constexpr (GA) { _Pragma("unroll") for (int _i = 0; _i < 2; ++_i) \
        __builtin_amdgcn_global_load_lds((const unsigned*)((const char*)(gk) + AR_[h_][_i] + C02), (LAS unsigned*)(lds + (bufoff) + ldsw + _i * 8192), 16, 0, 0); } \
        else if constexpr (AB) { _Pragma("unroll") for (int _i = 0; _i < 2; ++_i)     \
        __builtin_amdgcn_global_load_lds((const unsigned*)((const char*)(gk) + (size_t)(h_) * 524288 + (unsigned)((((wid >> 1) + 4 * _i) * 64 + (wid & 1)) * 1024 + lane * 16)), (LAS unsigned*)(lds + (bufoff) + ldsw + _i * 8192), 16, 0, 0); } \
        else PG8_STAGE(bufoff, (const char*)(gk) + (h_) * (hs_), K2_, R0); } while (0)
#define PG8_LDA(dst, b, h) do { _Pragma("unroll") for (int m = 0; m < 4; ++m) _Pragma("unroll") for (int k = 0; k < 2; ++k) dst[m][k] = *(const LAS bf16x8*)(lds + PG8_SA(b, h) + aoff + m * 2048 + k * 1024); } while (0)
#define PG8_LDB(dst, b, h) do { _Pragma("unroll") for (int n = 0; n < 2; ++n) _Pragma("unroll") for (int k = 0; k < 2; ++k) dst[n][k] = *(const LAS bf16x8*)(lds + PG8_SB(b, h) + boff + n * 2048 + k * 1024); } while (0)
#define PG8_MMA(ai, bj, At, Bt) do { __builtin_amdgcn_s_setprio(1); _Pragma("unroll") for (int m = 0; m < 4; ++m) _Pragma("unroll") for (int n = 0; n < 2; ++n) _Pragma("unroll") for (int k = 0; k < 2; ++k) \
        acc[ai][bj][m][n] = __builtin_amdgcn_mfma_f32_16x16x32_bf16(Bt[n][k], At[m][k], acc[ai][bj][m][n], 0, 0, 0); __builtin_amdgcn_s_setprio(0); } while (0)
#define PG8_WAIT_V(n) asm volatile("s_waitcnt vmcnt(" #n ")" ::: "memory")
#define PG8_WAIT_L(n) asm volatile("s_waitcnt lgkmcnt(" #n ")" ::: "memory")
#define PG8_BAR __builtin_amdgcn_s_barrier()
#define PG8_SCHED __builtin_amdgcn_sched_barrier(0)
    constexpr bool GA = Sched::GATHER;
    constexpr bool BP = Sched::BPERM;
    constexpr bool AB = Sched::ABLK;
    const size_t kstepA = AB ? (size_t)2048 : (size_t)(BK * 2);
    constexpr int IDXL = 133120;
    Unit cur, nxt; int ui = 0;
    if (!S.next(0, cur)) return;
    unsigned arc[2][2] = {{0u, 0u}, {0u, 0u}}, arn[2][2] = {{0u, 0u}, {0u, 0u}};
    if constexpr (GA) {
#pragma unroll
        for (int h = 0; h < 2; ++h)
#pragma unroll
            for (int i = 0; i < 2; ++i) arc[h][i] = (unsigned)S.rows(cur)[R0 + 64 * i + 128 * h] * (unsigned)cur.K2;
    }
    f32x4 acc[2][2][4][2];
#pragma unroll
    for (int a = 0; a < 2; ++a)
#pragma unroll
        for (int b = 0; b < 2; ++b)
#pragma unroll
            for (int m = 0; m < 4; ++m)
#pragma unroll
                for (int n = 0; n < 2; ++n) acc[a][b][m][n] = (f32x4){0.f, 0.f, 0.f, 0.f};
    bf16x8 At[4][2], B0[2][2], B1[2][2];
    const char* cA = cur.A; const char* cB = cur.B; int K2c = cur.K2; size_t hsc = (size_t)HALF * K2c;
    PG8_STAGE_B(PG8_SB(0, 0), cB, 0, hsc, K2c); PG8_STAGE_B(PG8_SB(0, 1), cB, 1, hsc, K2c); PG8_STAGE_A(PG8_SA(0, 0), cA, 0, hsc, K2c, arc); PG8_STAGE_A(PG8_SA(0, 1), cA, 1, hsc, K2c, arc);
    if (wr == 1) PG8_BAR;
    PG8_WAIT_V(2); PG8_BAR;
    PG8_STAGE_B(PG8_SB(1, 0), cB + kstep, 0, hsc, K2c); PG8_STAGE_A(PG8_SA(1, 0), cA + kstepA, 0, hsc, K2c, arc); PG8_STAGE_B(PG8_SB(1, 1), cB + kstep, 1, hsc, K2c);
    PG8_WAIT_V(6); PG8_BAR;
    for (;;) {
        const bool has_next = S.next(ui + 1, nxt);
        const char* nA = has_next ? nxt.A : cA; const char* nB = has_next ? nxt.B : cB; const int K2n = has_next ? nxt.K2 : K2c;
        const int nt = cur.nt;
        if constexpr (GA) {
            if (wid < 4) __builtin_amdgcn_global_load_lds((const unsigned*)(S.rows(has_next ? nxt : cur) + wid * 64 + lane), (LAS unsigned*)(lds + IDXL + wid * 256), 4, 0, 0);
        }
        for (int t = 0; t < nt; t += 2) {
            const bool last = (t == nt - 2);
            unsigned arx[2][2] = {{0u, 0u}, {0u, 0u}};
            if constexpr (GA) {
                if (last) {
#pragma unroll
                    for (int h = 0; h < 2; ++h)
#pragma unroll
                        for (int i = 0; i < 2; ++i) arn[h][i] = *(const LAS unsigned*)(lds + IDXL + 4 * (R0 + 64 * i + 128 * h)) * (unsigned)K2n;
                }
#pragma unroll
                for (int h = 0; h < 2; ++h)
#pragma unroll
                    for (int i = 0; i < 2; ++i) arx[h][i] = last ? arn[h][i] : arc[h][i];
            }
            const char* a1 = cA + (size_t)(t + 1) * kstepA;
            const char* a2 = last ? nA : cA + (size_t)(t + 2) * kstepA; const char* b2 = last ? nB : cB + (size_t)(t + 2) * kstep;
            const int K2x = last ? K2n : K2c; const size_t hsx = (size_t)HALF * K2x;
            const char* a3 = a2 + kstepA; const char* b3 = b2 + kstep;
            PG8_LDB(B0, 0, 0); PG8_LDB(B1, 0, 1); PG8_SCHED; PG8_LDA(At, 0, 0); PG8_STAGE_A(PG8_SA(1, 1), a1, 1, hsc, K2c, arc);
            PG8_WAIT_V(8); PG8_WAIT_L(0); PG8_BAR; PG8_MMA(0, 0, At, B0); PG8_MMA(0, 1, At, B1); PG8_BAR; PG8_SCHED;
            PG8_LDA(At, 0, 1); PG8_STAGE_B(PG8_SB(0, 0), b2, 0, hsx, K2x); PG8_STAGE_B(PG8_SB(0, 1), b2, 1, hsx, K2x); PG8_STAGE_A(PG8_SA(0, 0), a2, 0, hsx, K2x, arx);
            PG8_WAIT_V(8); PG8_WAIT_L(0); PG8_BAR; PG8_MMA(1, 0, At, B0); PG8_MMA(1, 1, At, B1); PG8_BAR; PG8_SCHED;
            PG8_LDB(B0, 1, 0); PG8_LDB(B1, 1, 1); PG8_SCHED; PG8_LDA(At, 1, 0); PG8_STAGE_A(PG8_SA(0, 1), a2, 1, hsx, K2x, arx);
            PG8_WAIT_V(8); PG8_WAIT_L(0); PG8_BAR; PG8_MMA(0, 0, At, B0); PG8_MMA(0, 1, At, B1); PG8_BAR; PG8_SCHED;
            PG8_LDA(At, 1, 1); PG8_STAGE_B(PG8_SB(1, 0), b3, 0, hsx, K2x); PG8_STAGE_B(PG8_SB(1, 1), b3, 1, hsx, K2x); PG8_STAGE_A(PG8_SA(1, 0), a3, 0, hsx, K2x, arx);
            PG8_WAIT_V(8); PG8_WAIT_L(0); PG8_BAR; PG8_MMA(1, 0, At, B0); PG8_MMA(1, 1, At, B1); PG8_BAR; PG8_SCHED;
        }
        if (wr == 0) PG8_BAR;
        const bool keep = E(acc, cur, wr, wc, fr, fq);
        if (!has_next) break;
        if (!keep) {
#pragma unroll
        for (int a = 0; a < 2; ++a)
#pragma unroll
            for (int b = 0; b < 2; ++b)
#pragma unroll
                for (int m = 0; m < 4; ++m)
#pragma unroll
                    for (int n = 0; n < 2; ++n) acc[a][b][m][n] = (f32x4){0.f, 0.f, 0.f, 0.f};
        }
        cur = nxt; cA = nA; cB = nB; K2c = K2n; hsc = (size_t)HALF * K2c; ++ui;
        if constexpr (GA) {
#pragma unroll
            for (int h = 0; h < 2; ++h)
#pragma unroll
                for (int i = 0; i < 2; ++i) arc[h][i] = arn[h][i];
        }
        if (wr == 1) PG8_BAR;
    }
    PG8_WAIT_V(0);
    PG8_BAR;
#undef PG8_SA
#undef PG8_SB
#undef PG8_STAGE
#undef PG8_STAGE_A
#undef PG8_STAGE_B
#undef PG8_LDA
#undef PG8_LDB
#undef PG8_MMA
#undef PG8_WAIT_V
#undef PG8_WAIT_L
#undef PG8_BAR
#undef PG8_SCHED
}

struct SchedPlain { static constexpr bool ABLK = false; static constexpr bool BPERM = true;          static constexpr bool GATHER = false; __device__ __forceinline__ const int* rows(const Unit&) const { return nullptr; }
    const char* A; const char* B; int K2, nt, nM, nN, G, c, bmode;
    __device__ __forceinline__ bool next(int i, Unit& u) const {
        const long L = (long)i * G + c; if (L >= (long)nM * nN) return false;
        tile_map((int)L, nM, nN, u.pm, u.pn);
        const int bt = bmode == 0 ? u.pn : (bmode == 1 ? (u.pm >> 4) * 16 + u.pn : (u.pm >> 4) * 4 + u.pn);
        u.A = A + (size_t)u.pm * 256 * K2; u.B = B + (size_t)bt * 256 * K2; u.K2 = K2; u.nt = nt; u.tag = 0; return true;
    }
};
struct SchedInProj {
    static constexpr bool GATHER = false, BPERM = true, ABLK = false; __device__ __forceinline__ const int* rows(const Unit&) const { return nullptr; }
    const char* A; const char* B; int G, c;
    __device__ __forceinline__ bool next(int i, Unit& u) const {
        const long L = (long)i * G + c; if (L >= 128L * 34) return false;
        tile_map((int)L, 128, 34, u.pm, u.pn);
        u.A = A + (size_t)u.pm * 256 * 2048; u.B = B + (size_t)u.pn * 256 * 2048; u.K2 = 2048; u.nt = 16; u.tag = 0; return true;
    }
};
struct SchedFfnDown {
    static constexpr bool GATHER = false, BPERM = true, ABLK = true;
    __device__ __forceinline__ const int* rows(const Unit&) const { return nullptr; }
    const char* A; const char* B; int G, c;
    __device__ __forceinline__ bool next(int i, Unit& u) const {
        const long L = (long)i * G + c; if (L >= 256L * 4) return false;
        tile_map((int)L, 256, 4, u.pm, u.pn);
        u.A = A + (size_t)u.pm * 256 * 4096; u.B = B + (size_t)((u.pm >> 4) * 4 + u.pn) * 256 * 4096; u.K2 = 4096; u.nt = 32; u.tag = 0; return true;
    }
};
struct SchedFfnUp { static constexpr bool ABLK = false; static constexpr bool BPERM = false;
    static constexpr bool GATHER = true;
    const char* X; const char* B; const int* idx; int G, c;
    __device__ __forceinline__ const int* rows(const Unit& u) const { return idx + u.pm * 256; }
    __device__ __forceinline__ bool next(int i, Unit& u) const {
        const long L = (long)i * G + c; if (L >= 256L * 16) return false;
        tile_map((int)L, 256, 16, u.pm, u.pn);
        u.A = X; u.B = B + (size_t)((u.pm >> 4) * 16 + u.pn) * 256 * 2048; u.K2 = 2048; u.nt = 16; u.tag = 0; return true;
    }
};
struct SchedMerge { static constexpr bool ABLK = false; static constexpr bool BPERM = true;     static constexpr bool GATHER = false; __device__ __forceinline__ const int* rows(const Unit&) const { return nullptr; }
    const char* ws; int G, c;
    __device__ __forceinline__ bool next(int i, Unit& u) const {
        const long L = (long)(i >> 2) * G + c; if (L >= 128 * 4) return false;
        tile_map((int)L, 128, 4, u.pm, u.pn);
        const int b = i & 3; u.tag = b;
        const int ge1 = b >= 1 ? 1 : 0, ge2 = b >= 2 ? 1 : 0, ge3 = b >= 3 ? 1 : 0;
        const int K2 = 768 - ge2 * 256 + ge3 * 512;
        const size_t yoff = WS_YA + (size_t)ge1 * (WS_YB - WS_YA) + (size_t)ge2 * (WS_YC - WS_YB) + (size_t)ge3 * (WS_YD - WS_YC);
        const size_t woff = WS_WNA + (size_t)ge1 * (WS_WGQA - WS_WNA) + (size_t)ge2 * (WS_WDIL - WS_WGQA) + (size_t)ge3 * (WS_WDIFF - WS_WDIL);
        u.K2 = K2; u.nt = K2 >> 7; u.A = ws + yoff + (size_t)u.pm * 256 * K2; u.B = ws + woff + (size_t)u.pn * 256 * K2;
        return true;
    }
};
struct SchedPle { static constexpr bool ABLK = false; static constexpr bool BPERM = true;       static constexpr bool GATHER = false; __device__ __forceinline__ const int* rows(const Unit&) const { return nullptr; }
    const char* XB; const char* WPG; const char* PB; const char* WPP; int G, c;
    __device__ __forceinline__ bool next(int i, Unit& u) const {
        const long L = (long)(i >> 1) * G + c; if (L >= 128 * 4) return false;
        tile_map((int)L, 128, 4, u.pm, u.pn);
        u.tag = i & 1;
        if (u.tag == 0) { u.K2 = 2048; u.nt = 16; u.A = XB + (size_t)u.pm * 256 * 2048; u.B = WPG + (size_t)u.pn * 256 * 2048; }
        else { u.K2 = 512; u.nt = 4; u.A = PB + (size_t)u.pm * 256 * 512; u.B = WPP + (size_t)u.pn * 256 * 512; }
        return true;
    }
};

#define EPI_ROWS_BEGIN  _Pragma("unroll") for (int ai = 0; ai < 2; ++ai) _Pragma("unroll") for (int m = 0; m < 4; ++m) { const int row = u.pm * 256 + ai * 128 + wr * 64 + m * 16 + fr;
#define EPI_ROWS_END    }
__device__ __forceinline__ u32x4 pack8(const f32x4 v0, const f32x4 v1) { u32x4 w; w.x = cvt_pk_bf16(v0[0], v0[1]); w.y = cvt_pk_bf16(v0[2], v0[3]); w.z = cvt_pk_bf16(v1[0], v1[1]); w.w = cvt_pk_bf16(v1[2], v1[3]); return w; }

__device__ __forceinline__ u32x4 ld16_sc1(const void* p) {
    const unsigned long long a = __hip_atomic_load((const unsigned long long*)p, __ATOMIC_RELAXED, __HIP_MEMORY_SCOPE_AGENT);
    const unsigned long long b = __hip_atomic_load((const unsigned long long*)p + 1, __ATOMIC_RELAXED, __HIP_MEMORY_SCOPE_AGENT);
    u32x4 r; r.x = (unsigned)a; r.y = (unsigned)(a >> 32); r.z = (unsigned)b; r.w = (unsigned)(b >> 32); return r; }
__device__ __forceinline__ f32x4 ld16f_sc1(const void* p) { return __builtin_bit_cast(f32x4, ld16_sc1(p)); }
struct EpiInProj {
    bf16_t* H; bf16_t* S;
    static __device__ __forceinline__ u32x4 swap1(const u32x4 v) { u32x4 r; r.x = (unsigned)__builtin_amdgcn_update_dpp(0, (int)v.x, 0xB1, 0xF, 0xF, false); r.y = (unsigned)__builtin_amdgcn_update_dpp(0, (int)v.y, 0xB1, 0xF, 0xF, false);
        r.z = (unsigned)__builtin_amdgcn_update_dpp(0, (int)v.z, 0xB1, 0xF, 0xF, false); r.w = (unsigned)__builtin_amdgcn_update_dpp(0, (int)v.w, 0xB1, 0xF, 0xF, false); return r; }
    __device__ __forceinline__ bool operator()(f32x4 (&acc)[2][2][4][2], const Unit& u, int wr, int wc, int fr_, int fq) const {
        int fr = fr_; asm volatile("" : "+v"(fr));
        const bool odd = (fr & 1) != 0;
        const int cw = wc * 64 + 8 * fq + (odd ? 32 : 0);
        const int re = wr * 64 + (fr & ~1);
#define INPROJ_STORE(rp_, ld_, w0_, w1_) do { const u32x4 send_ = odd ? (w0_) : (w1_), recv_ = swap1(send_); \
            __builtin_nontemporal_store(odd ? recv_ : (w0_), (u32x4*)(rp_)); __builtin_nontemporal_store(odd ? (w1_) : recv_, (u32x4*)((rp_) + (ld_))); } while (0)
        if (u.pn < 18) {
            bf16_t* base = H + (size_t)(u.pm * 256 + re) * HW + u.pn * 256 + cw;
#pragma unroll
            for (int ai = 0; ai < 2; ++ai)
#pragma unroll
                for (int m = 0; m < 4; ++m) { const u32x4 w0 = pack8(acc[ai][0][m][0], acc[ai][0][m][1]), w1 = pack8(acc[ai][1][m][0], acc[ai][1][m][1]);
                    INPROJ_STORE(base + (size_t)(ai * 128 + m * 16) * HW, HW, w0, w1); }
        } else {
            bf16_t* base = S + (size_t)(u.pm * 256 + re) * NGATE + (u.pn - 18) * 256 + cw;
#pragma unroll
            for (int ai = 0; ai < 2; ++ai)
#pragma unroll
                for (int m = 0; m < 4; ++m) {
                    f32x4 a0 = acc[ai][0][m][0], a1 = acc[ai][0][m][1], b0 = acc[ai][1][m][0], b1 = acc[ai][1][m][1];
#pragma unroll
                    for (int j = 0; j < 4; ++j) { a0[j] = fmaxf(fast_sigmoid(a0[j]), 1e-18f); a1[j] = fmaxf(fast_sigmoid(a1[j]), 1e-18f); b0[j] = fmaxf(fast_sigmoid(b0[j]), 1e-18f); b1[j] = fmaxf(fast_sigmoid(b1[j]), 1e-18f); }
                    const u32x4 w0 = pack8(a0, a1), w1 = pack8(b0, b1);
                    INPROJ_STORE(base + (size_t)(ai * 128 + m * 16) * NGATE, NGATE, w0, w1); }
        }
#undef INPROJ_STORE
        return false;
    }
};
struct EpiGateAcc {
    const bf16_t* S; bf16_t* MG;
    __device__ __forceinline__ bool operator()(f32x4 (&acc)[2][2][4][2], const Unit& u, int wr, int wc, int fr_, int fq) const {
        int fr = fr_; asm volatile("" : "+v"(fr));
        const bool odd = (fr & 1) != 0; const int b = u.tag;
        const int cw = u.pn * 256 + wc * 64 + 8 * fq + (odd ? 32 : 0);
        const size_t rowe = (size_t)(u.pm * 256 + wr * 64 + (fr & ~1));
        const bf16_t* sc = S + rowe * NGATE + b * 1024 + cw;
#pragma unroll
        for (int ai = 0; ai < 2; ++ai) {
                u32x4 l0[4][2], l1[4][2];
#pragma unroll
                for (int mm = 0; mm < 4; ++mm)
#pragma unroll
                    for (int par = 0; par < 2; ++par) {
                        const size_t ro = (size_t)(ai * 128 + mm * 16 + par) * NGATE;
                        l0[mm][par] = *(const u32x4*)(sc + ro);
                        if (b < 3) l1[mm][par] = *(const u32x4*)(sc + ro + 1024); else l1[mm][par] = (u32x4){0x3f803f80u, 0x3f803f80u, 0x3f803f80u, 0x3f803f80u};
                    }
                asm volatile("" ::: "memory");
#pragma unroll
                for (int mm = 0; mm < 4; ++mm) {
                    const int m = mm;
                    const u32x4 ar = EpiInProj::swap1(odd ? l0[mm][0] : l0[mm][1]), dr = EpiInProj::swap1(odd ? l1[mm][0] : l1[mm][1]);
                    const u32x4 a0 = odd ? ar : l0[mm][0], a1 = odd ? l0[mm][1] : ar, d0 = odd ? dr : l1[mm][0], d1 = odd ? l1[mm][1] : dr;
                    u32x4 wout[2];
#pragma unroll
                    for (int bj = 0; bj < 2; ++bj) {
                        const u32x4 a = bj ? a1 : a0, d = bj ? d1 : d0;
                        f32x4 v0 = acc[ai][bj][m][0], v1 = acc[ai][bj][m][1];
                        v0[0] *= bf_lo(a.x) * __builtin_amdgcn_rcpf(bf_lo(d.x)); v0[1] *= bf_hi(a.x) * __builtin_amdgcn_rcpf(bf_hi(d.x)); v0[2] *= bf_lo(a.y) * __builtin_amdgcn_rcpf(bf_lo(d.y)); v0[3] *= bf_hi(a.y) * __builtin_amdgcn_rcpf(bf_hi(d.y));
                        v1[0] *= bf_lo(a.z) * __builtin_amdgcn_rcpf(bf_lo(d.z)); v1[1] *= bf_hi(a.z) * __builtin_amdgcn_rcpf(bf_hi(d.z)); v1[2] *= bf_lo(a.w) * __builtin_amdgcn_rcpf(bf_lo(d.w)); v1[3] *= bf_hi(a.w) * __builtin_amdgcn_rcpf(bf_hi(d.w));
                        acc[ai][bj][m][0] = v0; acc[ai][bj][m][1] = v1;
                        wout[bj] = pack8(v0, v1);
                    }
                    if (b == 3) { const u32x4 rv = EpiInProj::swap1(odd ? wout[0] : wout[1]);
                        bf16_t* rp = MG + (rowe + ai * 128 + m * 16) * DM + cw;
                        *(u32x4*)rp = odd ? rv : wout[0]; *(u32x4*)(rp + DM) = odd ? wout[1] : rv; }
                }
                asm volatile("" ::: "memory");
            }
        return b < 3;
    }
};
struct EpiResid {
    const bf16_t* X; bf16_t* Z;
    __device__ __forceinline__ bool operator()(f32x4 (&acc)[2][2][4][2], const Unit& u, int wr, int wc, int fr_, int fq) const {
        int fr = fr_; asm volatile("" : "+v"(fr));
        const bool odd = (fr & 1) != 0;
        const size_t off0 = (size_t)(u.pm * 256 + wr * 64 + (fr & ~1)) * DM + u.pn * 256 + wc * 64 + 8 * fq + (odd ? 32 : 0);
#pragma unroll
        for (int ai = 0; ai < 2; ++ai) {
            u32x4 xl[4][2];
#pragma unroll
            for (int m = 0; m < 4; ++m)
#pragma unroll
                for (int par = 0; par < 2; ++par) xl[m][par] = *(const u32x4*)(X + off0 + (size_t)(ai * 128 + m * 16 + par) * DM);
            asm volatile("" ::: "memory");
#pragma unroll
            for (int m = 0; m < 4; ++m) {
                const u32x4 xr = EpiInProj::swap1(odd ? xl[m][0] : xl[m][1]);
                const u32x4 x0 = odd ? xr : xl[m][0], x1 = odd ? xl[m][1] : xr;
                u32x4 wout[2];
#pragma unroll
                for (int bj = 0; bj < 2; ++bj) { const u32x4 x = bj ? x1 : x0;
                    f32x4 z0 = acc[ai][bj][m][0], z1 = acc[ai][bj][m][1];
                    z0[0] += ALPHA * bf_lo(x.x); z0[1] += ALPHA * bf_hi(x.x); z0[2] += ALPHA * bf_lo(x.y); z0[3] += ALPHA * bf_hi(x.y);
                    z1[0] += ALPHA * bf_lo(x.z); z1[1] += ALPHA * bf_hi(x.z); z1[2] += ALPHA * bf_lo(x.w); z1[3] += ALPHA * bf_hi(x.w);
                    wout[bj] = pack8(z0, z1); }
                const u32x4 rv = EpiInProj::swap1(odd ? wout[0] : wout[1]);
                bf16_t* rp = Z + off0 + (size_t)(ai * 128 + m * 16) * DM;
                *(u32x4*)rp = odd ? rv : wout[0]; *(u32x4*)(rp + DM) = odd ? wout[1] : rv; }
            asm volatile("" ::: "memory");
        }
        return false;
    }
};
struct EpiSwiGLU {
    bf16_t* HID;
    __device__ __forceinline__ bool operator()(f32x4 (&acc)[2][2][4][2], const Unit& u, int wr, int wc, int fr, int fq) const {
        char* hb = (char*)HID + ((size_t)((u.pm * 16 + wr * 4) * 64 + u.pn * 4 + wc) * 1024) + (fr * 64 + ((fq ^ ((fr >> 3) << 1)) * 16));
        EPI_ROWS_BEGIN
            f32x4 g0 = acc[ai][0][m][0], g1 = acc[ai][0][m][1]; const f32x4 u0 = acc[ai][1][m][0], u1 = acc[ai][1][m][1];
#pragma unroll
            for (int j = 0; j < 4; ++j) { g0[j] = g0[j] * fast_sigmoid(g0[j]) * u0[j]; g1[j] = g1[j] * fast_sigmoid(g1[j]) * u1[j]; }
            (void)row; __builtin_nontemporal_store(pack8(g0, g1), (u32x4*)(hb + (size_t)((ai * 8 + m) * 64) * 1024));
        EPI_ROWS_END
            return false;
    }
};
struct EpiRowScale {    static constexpr int NST = 16;
    bf16_t* YO; const float* gate;
    __device__ __forceinline__ bool operator()(f32x4 (&acc)[2][2][4][2], const Unit& u, int wr, int wc, int fr_, int fq) const {
        int fr = fr_; asm volatile("" : "+v"(fr));
        const bool odd = (fr & 1) != 0;
        const int cw = u.pn * 256 + wc * 64 + 8 * fq + (odd ? 32 : 0);
        float g8[2][4];
#pragma unroll
        for (int ai = 0; ai < 2; ++ai)
#pragma unroll
            for (int m = 0; m < 4; ++m) g8[ai][m] = gate[u.pm * 256 + ai * 128 + wr * 64 + m * 16 + fr];
        asm volatile("" ::: "memory");
        bf16_t* base = YO + (size_t)(u.pm * 256 + wr * 64 + (fr & ~1)) * DM + cw;
#pragma unroll
        for (int ai = 0; ai < 2; ++ai)
#pragma unroll
            for (int m = 0; m < 4; ++m) { const float g = g8[ai][m];
                const u32x4 w0 = pack8(acc[ai][0][m][0] * g, acc[ai][0][m][1] * g), w1 = pack8(acc[ai][1][m][0] * g, acc[ai][1][m][1] * g);
                const u32x4 send = odd ? w0 : w1, recv = EpiInProj::swap1(send);
                bf16_t* rp = base + (size_t)(ai * 128 + m * 16) * DM;
                *(u32x4*)rp = odd ? recv : w0; *(u32x4*)(rp + DM) = odd ? w1 : recv; }
        return false;
    }
};
struct EpiPle {
    bf16_t* SC; const bf16_t* X; bf16_t* Z;
    __device__ __forceinline__ bool operator()(f32x4 (&acc)[2][2][4][2], const Unit& u, int wr, int wc, int fr_, int fq) const {
        int fr = fr_; asm volatile("" : "+v"(fr));
        const int tag = u.tag;
        u32x4* scp = (u32x4*)SC + ((size_t)((u.pm * 4 + u.pn) * 8 + wr * 4 + wc) * 16) * 64 + (fq * 16 + fr);
        if (tag == 0) {
#pragma unroll
            for (int ai = 0; ai < 2; ++ai)
#pragma unroll
                for (int m = 0; m < 4; ++m)
#pragma unroll
                    for (int bj = 0; bj < 2; ++bj) {
                        f32x4 v0 = acc[ai][bj][m][0], v1 = acc[ai][bj][m][1];
#pragma unroll
                        for (int j = 0; j < 4; ++j) { v0[j] = fast_sigmoid(v0[j]); v1[j] = fast_sigmoid(v1[j]); }
                        scp[(ai * 8 + m * 2 + bj) * 64] = pack8(v0, v1);
                    }
            return false;
        }
        const bool odd = (fr & 1) != 0;
        const size_t off0 = (size_t)(u.pm * 256 + wr * 64 + (fr & ~1)) * DM + u.pn * 256 + wc * 64 + 8 * fq + (odd ? 32 : 0);
#pragma unroll
        for (int ai = 0; ai < 2; ++ai) {
            u32x4 sv[4][2], xl[4][2];
#pragma unroll
            for (int m = 0; m < 4; ++m)
#pragma unroll
                for (int k = 0; k < 2; ++k) { sv[m][k] = scp[(ai * 8 + m * 2 + k) * 64]; xl[m][k] = *(const u32x4*)(X + off0 + (size_t)(ai * 128 + m * 16 + k) * DM); }
            asm volatile("" ::: "memory");
#pragma unroll
            for (int m = 0; m < 4; ++m) {
                const u32x4 xr = EpiInProj::swap1(odd ? xl[m][0] : xl[m][1]);
                const u32x4 x0 = odd ? xr : xl[m][0], x1 = odd ? xl[m][1] : xr;
                u32x4 wout[2];
#pragma unroll
                for (int bj = 0; bj < 2; ++bj) { const u32x4 x = bj ? x1 : x0, sw = sv[m][bj];
                    const f32x4 v0 = acc[ai][bj][m][0], v1 = acc[ai][bj][m][1];
                    f32x4 z0, z1;
                    z0[0] = ALPHA * bf_lo(x.x) + bf_lo(sw.x) * v0[0]; z0[1] = ALPHA * bf_hi(x.x) + bf_hi(sw.x) * v0[1]; z0[2] = ALPHA * bf_lo(x.y) + bf_lo(sw.y) * v0[2]; z0[3] = ALPHA * bf_hi(x.y) + bf_hi(sw.y) * v0[3];
                    z1[0] = ALPHA * bf_lo(x.z) + bf_lo(sw.z) * v1[0]; z1[1] = ALPHA * bf_hi(x.z) + bf_hi(sw.z) * v1[1]; z1[2] = ALPHA * bf_lo(x.w) + bf_lo(sw.w) * v1[2]; z1[3] = ALPHA * bf_hi(x.w) + bf_hi(sw.w) * v1[3];
                    wout[bj] = pack8(z0, z1); }
                const u32x4 rv = EpiInProj::swap1(odd ? wout[0] : wout[1]);
                bf16_t* rp = Z + off0 + (size_t)(ai * 128 + m * 16) * DM;
                *(u32x4*)rp = odd ? rv : wout[0]; *(u32x4*)(rp + DM) = odd ? wout[1] : rv; }
            asm volatile("" ::: "memory");
        }
        return false;
    }
};
}

namespace att {
constexpr int KCH = 1040, KSLOT = 8 * KCH;
constexpr int VDQ = 4160, VSLOT = 4 * VDQ;
constexpr int L_K = 0, L_V = 3 * KSLOT, L_WS = L_V + 4 * VSLOT, L_TAB = L_WS + 8 * 256;
constexpr float NEG_BIG = -1e30f;
__device__ __forceinline__ int crow(int r, int hi) { return (r & 3) + 8 * (r >> 2) + 4 * hi; }
__device__ __forceinline__ float swap32(float v) { auto rr = __builtin_amdgcn_permlane32_swap(__float_as_uint(v), __float_as_uint(v), false, false); return __uint_as_float(rr[0] == __float_as_uint(v) ? rr[1] : rr[0]); }
__device__ __forceinline__ float xhalf_max(float v) { auto rr = __builtin_amdgcn_permlane32_swap(__float_as_uint(v), __float_as_uint(v), false, false); return fmaxf(__uint_as_float(rr[0]), __uint_as_float(rr[1])); }
__device__ __forceinline__ float xhalf_sum(float v) { auto rr = __builtin_amdgcn_permlane32_swap(__float_as_uint(v), __float_as_uint(v), false, false); return __uint_as_float(rr[0]) + __uint_as_float(rr[1]); }
__device__ __forceinline__ s16x4 vtr(LAS const char* p) { typedef short v4i16_t __attribute__((ext_vector_type(4))); return __builtin_bit_cast(s16x4, __builtin_amdgcn_ds_read_tr16_b64_v4i16((LAS v4i16_t*)p)); }
__device__ __forceinline__ int t5_bucket(int rel) {
    const int n = rel < 0 ? -rel : rel; int b;
    if (n < 8) b = n; else b = n >= 559 ? 15 : n >= 305 ? 14 : n >= 166 ? 13 : n >= 91 ? 12 : n >= 50 ? 11 : n >= 27 ? 10 : n >= 15 ? 9 : 8;
    return b + (rel > 0 ? 16 : 0);
}

struct ModNone {
    __device__ __forceinline__ bool active(int) const { return true; }
    __device__ __forceinline__ int tile_code(int) const { return 0; }
    __device__ __forceinline__ float code_const(int) const { return 0.f; }
    __device__ __forceinline__ void apply(f32x16&, f32x16&, int) const {}
};
struct ModD {
    LAS const float* tb; int q, qw0, hi; float cneg, cpos;
    __device__ __forceinline__ bool active(int) const { return true; }
    __device__ __forceinline__ int tile_code(int t) const { const int kv0 = t * 64; return (kv0 + 63 - qw0 <= -559) ? 1 : ((kv0 - (qw0 + 31) >= 559) ? 2 : 0); }
    __device__ __forceinline__ float code_const(int c) const { return c == 1 ? cneg : (c == 2 ? cpos : 0.f); }
    __device__ __forceinline__ void apply(f32x16& p0, f32x16& p1, int t) const {
        const int kv0 = t * 64;
        if (!(kv0 + 63 - qw0 <= -559) && !(kv0 - (qw0 + 31) >= 559)) {
            int base = kv0 - q + 1024 + 4 * hi; asm volatile("" : "+v"(base));
            const LAS float* tp = tb + base;
#pragma unroll
            for (int r = 0; r < 16; ++r) { p0[r] += tp[(r & 3) + 8 * (r >> 2)]; p1[r] += tp[(r & 3) + 8 * (r >> 2) + 32]; }
        }
    }
};
template <int SH> struct ModC {
    LAS const float* tc; int q, qw0, hi;
    static constexpr int SPAN = 64 << SH, MSK = (1 << SH) - 1;
    __device__ __forceinline__ bool active(int t) const { const int kv0 = t * 64; return (kv0 + 63 >= qw0 - SPAN) && (kv0 <= qw0 + 31 + SPAN); }
    __device__ __forceinline__ int tile_code(int) const { return 0; }
    __device__ __forceinline__ float code_const(int) const { return 0.f; }
    __device__ __forceinline__ void apply(f32x16& p0, f32x16& p1, int t) const {
        const int kv0 = t * 64;
        int base = kv0 - q + 4 * hi; asm volatile("" : "+v"(base));
        const LAS float* tp = tc + ((base >> SH) + 192);
        const int bm = base & MSK;
        const bool inner = (kv0 >= qw0 + 31 - SPAN) && (kv0 + 63 <= qw0 + SPAN);
        if (inner) {
#pragma unroll
            for (int r = 0; r < 16; ++r) {
                constexpr int dummy = 0; (void)dummy;
                const int K0 = (r & 3) + 8 * (r >> 2), K1 = K0 + 32;
                const int C0 = (K0 >> SH) + ((K0 & MSK) ? 1 : 0), C1 = (K1 >> SH) + ((K1 & MSK) ? 1 : 0);
                const bool ok0 = bm == ((-K0) & MSK), ok1 = bm == ((-K1) & MSK);
                const float b0 = tp[C0], b1 = tp[C1];
                p0[r] = ok0 ? p0[r] + b0 : -INFINITY; p1[r] = ok1 ? p1[r] + b1 : -INFINITY;
            }
        } else {
            const int bs = base + SPAN;
#pragma unroll
            for (int r = 0; r < 16; ++r) {
                const int K0 = (r & 3) + 8 * (r >> 2), K1 = K0 + 32;
                const int C0 = (K0 >> SH) + ((K0 & MSK) ? 1 : 0), C1 = (K1 >> SH) + ((K1 & MSK) ? 1 : 0);
                const bool ok0 = (bm == ((-K0) & MSK)) && ((unsigned)(bs + K0) <= (unsigned)(2 * SPAN)), ok1 = (bm == ((-K1) & MSK)) && ((unsigned)(bs + K1) <= (unsigned)(2 * SPAN));
                const float b0 = tp[C0], b1 = tp[C1];
                p0[r] = ok0 ? p0[r] + b0 : -INFINITY; p1[r] = ok1 ? p1[r] + b1 : -INFINITY;
            }
        }
    }
};
struct ModA {
    LAS const float* tab; int r, rs, w  , cb  ;
    __device__ __forceinline__ bool active(int t) const { return t >= rs && t < rs + 8; }
    __device__ __forceinline__ int tile_code(int) const { return 0; }
    __device__ __forceinline__ float code_const(int) const { return 0.f; }
    __device__ __forceinline__ void apply(f32x16& p0, f32x16& p1, int t) const {
        int base = (t - r + 7) * 128 + cb; asm volatile("" : "+v"(base));
        const LAS float* tp = tab + base;
#pragma unroll
        for (int i = 0; i < 16; ++i) {
            const int K0 = (i & 3) + 8 * (i >> 2), K1 = K0 + 32;
            const bool ok0 = (unsigned)(K0 - w) < 16u, ok1 = (unsigned)(K1 - w) < 16u;
            const float b0 = tp[K0], b1 = tp[K1];
            p0[i] = ok0 ? p0[i] + b0 : -INFINITY; p1[i] = ok1 ? p1[i] + b1 : -INFINITY;
        }
    }
};

#define ATT_WAITV(n) asm volatile("s_waitcnt vmcnt(" #n ")" ::: "memory")
#define ATT_BAR() do { asm volatile("s_waitcnt lgkmcnt(0)" ::: "memory"); __builtin_amdgcn_s_barrier(); asm volatile("" ::: "memory"); } while (0)
__device__ __forceinline__ void glds16(const void* gsrc, unsigned lds_dst) {
    asm volatile("s_mov_b32 m0, %1\n\ts_nop 0\n\tglobal_load_lds_dwordx4 %0, off" : : "v"(gsrc), "s"(lds_dst) : "memory", "m0"); }
__device__ __forceinline__ void glds16s(unsigned voff, const void* sbase, unsigned lds_dst) {
    asm volatile("s_mov_b32 m0, %2\n\ts_nop 0\n\tglobal_load_lds_dwordx4 %0, %1" : : "v"(voff), "s"(sbase), "s"(lds_dst) : "memory", "m0"); }
__device__ __forceinline__ void glds16s_o128(unsigned voff, const void* sbase, unsigned lds_dst) {
    asm volatile("s_mov_b32 m0, %2\n\ts_nop 0\n\tglobal_load_lds_dwordx4 %0, %1 offset:128" : : "v"(voff), "s"(sbase), "s"(lds_dst) : "memory", "m0"); }
constexpr int L_SIDE = 102400;
struct SideNone { static constexpr bool ON = false; };
struct SideConv { static constexpr bool ON = true; const float* eg; const float* eu; const float* ed; unsigned char* ws; int g; };
struct SideTile { const char* src; char* dst; int sh_src, sh_dst; };
__device__ __forceinline__ SideTile side_tile(const SideConv& s, int g) {
    const int which = g >> 13, e = (g >> 9) & 15, r = g & 511;
    SideTile T;
    if (which < 2) { const int kb = r >> 5, n0 = (r & 31) * 64;
        const float* base = which ? s.eu : s.eg;
        T.src = (const char*)(base + ((size_t)e * DM + kb * 64) * FF + n0); T.sh_src = 13;
        const int row0 = e * 4096 + (n0 >> 7) * 256 + which * 128 + (n0 & 127);
        T.dst = (char*)(s.ws + WS_WGU) + ((size_t)row0 * DM + kb * 64) * 2; T.sh_dst = 11; }
    else { const int kb = r >> 4, n0 = (r & 15) * 64;
        T.src = (const char*)(s.ed + ((size_t)e * FF + kb * 64) * DM + n0); T.sh_src = 12;
        T.dst = (char*)(s.ws + WS_WD) + ((size_t)(e * DM + n0) * FF + kb * 64) * 2; T.sh_dst = 12; }
    return T;
}
__device__ __forceinline__ void side_issue(const SideTile& T, unsigned lds0, int wid, int lane) {
    const unsigned kk = (unsigned)(8 * wid + (lane >> 4));
    const unsigned j16 = (unsigned)(((lane & 15) ^ (2 * wid)) * 16);
    glds16s((kk << T.sh_src) + j16, T.src, lds0 + L_SIDE + (2 * wid) * 1024);
    glds16s(((kk + 4) << T.sh_src) + j16, T.src, lds0 + L_SIDE + (2 * wid + 1) * 1024);
}
__device__ __forceinline__ void side_consume(const SideTile& T, LAS char* shm, int wid, int lane) {
    const int c = lane & 7, nn = lane >> 3;
    LAS const float* sp = (LAS const float*)(shm + L_SIDE + c * 2048 + (((2 * wid + (nn >> 2)) ^ (2 * c)) * 16) + (nn & 3) * 4);
    const float f0 = sp[0], f1 = sp[64], f2 = sp[128], f3 = sp[192], f4 = sp[256], f5 = sp[320], f6 = sp[384], f7 = sp[448];
    u32x4 o; o.x = cvt_pk_bf16(f0, f1); o.y = cvt_pk_bf16(f2, f3); o.z = cvt_pk_bf16(f4, f5); o.w = cvt_pk_bf16(f6, f7);
    __builtin_nontemporal_store(o, (u32x4*)(T.dst + ((size_t)(8 * wid + nn) << T.sh_dst) + 16 * c));
}
template <int DV>
__device__ __forceinline__ void attn_pre(LAS char* shm, const bf16_t* Kp, const bf16_t* Vp, int t0, int t1, int wid, int lane, const int rsh = 0) {
    if (t0 >= t1) return;
    const unsigned kvoff = (unsigned)(((lane * HW) << rsh) + wid * 8) * 2u;
    const unsigned vvoff = (unsigned)(((((wid & 3) * 16 + (lane >> 2)) * HW) << rsh) + (wid >> 2) * 32 + (lane & 3) * 8) * 2u;
    const unsigned lds0 = (unsigned)(uintptr_t)shm;
    const unsigned kdst = lds0 + L_K + wid * KCH, vdst = lds0 + L_V + (wid >> 2) * VDQ + (wid & 3) * 1024;
    asm volatile("s_waitcnt vmcnt(0)" ::: "memory");
    ATT_BAR();
    const int tl = t1 - 1, tb = t0 + 1 < tl ? t0 + 1 : tl;
    const size_t ta_ = ((size_t)t0 * (64 * HW * 2)) << rsh, tb_ = ((size_t)tb * (64 * HW * 2)) << rsh;
    glds16s(kvoff, (const char*)Kp + ta_, kdst); glds16s(vvoff, (const char*)Vp + ta_, vdst);
    if (DV == 128) glds16s(vvoff, (const char*)Vp + ta_ + 128, vdst + 2 * VDQ);
    glds16s(kvoff, (const char*)Kp + tb_, kdst + KSLOT); glds16s(vvoff, (const char*)Vp + tb_, vdst + VSLOT);
    if (DV == 128) glds16s(vvoff, (const char*)Vp + tb_ + 128, vdst + 2 * VDQ + VSLOT);
}
template <int DV, class Mod, class Side = SideNone, bool PRE = false>
__device__ __forceinline__ void attn_pass(LAS char* shm, const bf16_t* Kp, const bf16_t* Vp, int t0, int t1, const bf16x8 (&q)[4], const Mod& mod, float& mhat, float& lsum, bool& unset, f32x16 (&o)[DV / 32], int tid, int wid, int lane, int grp, const Side& side = Side{}, const int rsh = 0  ) {
    static_assert(!Side::ON || DV == 64, "the side stream's counted waits are written for the 64-wide pass");
    constexpr bool FOLD = true;
    const int r32 = lane & 31, hi = lane >> 5;
    if (t0 >= t1) return;
    LAS float* wsf = (LAS float*)(shm + L_WS) + wid * 64;
    const int kfo = hi * KCH + r32 * 16;
    const int vlo = ((lane >> 4) & 1) * 32 + (lane & 3) * 8 + (4 * hi + ((lane & 15) >> 2)) * 64;
    const unsigned kvoff = (unsigned)(((lane * HW) << rsh) + wid * 8) * 2u;
    const unsigned vvoff = (unsigned)(((((wid & 3) * 16 + (lane >> 2)) * HW) << rsh) + (wid >> 2) * 32 + (lane & 3) * 8) * 2u;
    const unsigned lds0 = (unsigned)(uintptr_t)shm;
    const unsigned kdst = lds0 + L_K + wid * KCH, vdst = lds0 + L_V + (wid >> 2) * VDQ + (wid & 3) * 1024;
#define ATT_DMA(t_, ko_, vo_) do { const size_t to_ = ((size_t)(t_) * (64 * HW * 2)) << rsh;         \
        glds16s(kvoff, (const char*)Kp + to_, kdst + (ko_)); \
        glds16s(vvoff, (const char*)Vp + to_, vdst + (vo_)); \
        if (DV == 128) glds16s(vvoff, (const char*)Vp + to_ + 128, vdst + 2 * VDQ + (vo_)); } while (0)
#define ATT_WAIT_TILE() do { if (DV == 128) ATT_WAITV(3); else ATT_WAITV(2); } while (0)
#define ATT_SB() __builtin_amdgcn_sched_barrier(0)
#define ATT_KLD(ko_) do { LAS const char* kp_ = shm + L_K + (ko_) + kfo; \
        _Pragma("unroll") for (int d0 = 0; d0 < 4; ++d0) { kf[2 * d0] = *(LAS const bf16x8*)(kp_ + d0 * 2 * KCH); kf[2 * d0 + 1] = *(LAS const bf16x8*)(kp_ + d0 * 2 * KCH + 512); } } while (0)
#define ATT_QKM() do { \
        if (FOLD) { p0 = __builtin_amdgcn_mfma_f32_32x32x16_bf16(kf[0], q[0], negm, 0, 0, 0); p1 = __builtin_amdgcn_mfma_f32_32x32x16_bf16(kf[1], q[0], negm, 0, 0, 0); } \
        else { p0 = __builtin_amdgcn_mfma_f32_32x32x16_bf16(kf[0], q[0], f32x16{}, 0, 0, 0); p1 = __builtin_amdgcn_mfma_f32_32x32x16_bf16(kf[1], q[0], f32x16{}, 0, 0, 0); } \
        _Pragma("unroll") for (int d0 = 1; d0 < 4; ++d0) { p0 = __builtin_amdgcn_mfma_f32_32x32x16_bf16(kf[2 * d0], q[d0], p0, 0, 0, 0); p1 = __builtin_amdgcn_mfma_f32_32x32x16_bf16(kf[2 * d0 + 1], q[d0], p1, 0, 0, 0); } } while (0)
#define ATT_VLD(dst_, dq_) do { _Pragma("unroll") for (int kc = 0; kc < 4; ++kc) { const s16x4 lo_ = vtr(vp + (dq_) * VDQ + kc * 1024), hh_ = vtr(vp + (dq_) * VDQ + kc * 1024 + 512); \
        dst_[kc] = (bf16x8){lo_[0], lo_[1], lo_[2], lo_[3], hh_[0], hh_[1], hh_[2], hh_[3]}; } } while (0)
#define ATT_PVM(src_, dq_) do { _Pragma("unroll") for (int kc = 0; kc < 4; ++kc) o[dq_] = __builtin_amdgcn_mfma_f32_32x32x16_bf16(__builtin_bit_cast(bf16x8, pw[kc]), src_[kc], o[dq_], 0, 0, 0); } while (0)
    const int tl = t1 - 1;
    if constexpr (!PRE) {
    asm volatile("s_waitcnt vmcnt(0)" ::: "memory");
    ATT_BAR();
    ATT_DMA(t0, 0, 0);
    ATT_DMA((t0 + 1 < tl ? t0 + 1 : tl), KSLOT, VSLOT);
    }
    ATT_WAIT_TILE();
    ATT_BAR();
    if (grp == 1) ATT_BAR();
    u32x4 pw[4];
    f32x16 negm, p0, p1;
    bf16x8 kf[8], va[4], vb[4];
    float cfold = 0.f; int ccode = 0;
#pragma unroll
    for (int r = 0; r < 16; ++r) negm[r] = -mhat;
#define ATT_CFOLD(t_) do { const int cn_ = mod.tile_code(t_); if (cn_ != ccode) { ccode = cn_; cfold = mod.code_const(cn_); _Pragma("unroll") for (int r = 0; r < 16; ++r) negm[r] = cfold - mhat; } } while (0)
    { ATT_DMA((t0 + 2 < tl ? t0 + 2 : tl), 2 * KSLOT, 2 * VSLOT);
      if (mod.active(t0)) { ATT_CFOLD(t0); ATT_KLD(0); ATT_QKM(); asm volatile("" : "+v"(p0), "+v"(p1)); }
      ATT_WAIT_TILE();
      ATT_SB(); ATT_BAR(); ATT_SB(); }
    int ko = 0, vo = 0;
    int sg = 0; if constexpr (Side::ON) sg = side.g;
    for (int t = t0; t < t1; ++t) {
        const bool act = mod.active(t);
        if (act) {
            mod.apply(p0, p1, t);
            float mx = __builtin_fmaxf(__builtin_fmaxf(p0[0], p1[0]), p0[1]);
            mx = __builtin_fmaxf(mx, p1[1]);
#pragma unroll
            for (int r = 2; r < 16; ++r) mx = __builtin_fmaxf(__builtin_fmaxf(mx, p0[r]), p1[r]);
            mx = xhalf_max(mx);
            const bool lane_resc = (mx > 8.0f) || (unset && mx > -INFINITY);
            if (__any(lane_resc)) {
                const float dl = lane_resc ? (unset ? mx : __builtin_fmaxf(mx, 0.f)) : 0.f;
                const float f = unset ? 0.f : __builtin_amdgcn_exp2f(-dl);
                mhat += dl; lsum *= f; unset = unset && !lane_resc;
#pragma unroll
                for (int r = 0; r < 16; ++r) { p0[r] -= dl; p1[r] -= dl; negm[r] = cfold - mhat; }
                if (hi == 0) wsf[r32] = f;
#pragma unroll
                for (int r = 0; r < 16; ++r) { const float fr_ = wsf[crow(r, hi)];
#pragma unroll
                    for (int dq = 0; dq < DV / 32; ++dq) o[dq][r] *= fr_; }
            }
            float sacc = 0.f;
#pragma unroll
            for (int r = 0; r < 16; ++r) { p0[r] = __builtin_amdgcn_exp2f(p0[r]); p1[r] = __builtin_amdgcn_exp2f(p1[r]); sacc += p0[r] + p1[r]; }
            lsum += sacc;
#pragma unroll
            for (int j = 0; j < 4; ++j) { pw[0][j] = cvt_pk_bf16(p0[2 * j], p0[2 * j + 1]); pw[1][j] = cvt_pk_bf16(p0[8 + 2 * j], p0[8 + 2 * j + 1]); pw[2][j] = cvt_pk_bf16(p1[2 * j], p1[2 * j + 1]); pw[3][j] = cvt_pk_bf16(p1[8 + 2 * j], p1[8 + 2 * j + 1]); }
            asm volatile("" : "+v"(pw[0]), "+v"(pw[1]), "+v"(pw[2]), "+v"(pw[3]), "+v"(lsum));
        }
        ATT_SB(); ATT_BAR(); ATT_SB();
        const int ko1 = ko == 2 * KSLOT ? 0 : ko + KSLOT;
        const int vom = vo == 0 ? 3 * VSLOT : vo - VSLOT;
        ATT_DMA((t + 3 < tl ? t + 3 : tl), ko, vom);
        const int sph = Side::ON ? ((t - t0) & 3) : 0;
        if constexpr (Side::ON) { if (sph == 0) { const SideTile T_ = side_tile(side, sg); side_issue(T_, lds0, wid, lane); } }
        const bool doqk = (t + 1 < t1) && mod.active(t + 1);
        LAS const char* vp = shm + L_V + vo + vlo;
        if (doqk) ATT_CFOLD(t + 1);
        if (true) {
            if (doqk) { LAS const char* kp_ = shm + L_K + ko1 + kfo;
#pragma unroll
                for (int d0 = 0; d0 < 2; ++d0) { kf[2 * d0] = *(LAS const bf16x8*)(kp_ + d0 * 2 * KCH); kf[2 * d0 + 1] = *(LAS const bf16x8*)(kp_ + d0 * 2 * KCH + 512); } }
            if (act) ATT_VLD(va, 0);
            ATT_SB();
            if (doqk) { LAS const char* kp_ = shm + L_K + ko1 + kfo;
                p0 = __builtin_amdgcn_mfma_f32_32x32x16_bf16(kf[0], q[0], negm, 0, 0, 0); p1 = __builtin_amdgcn_mfma_f32_32x32x16_bf16(kf[1], q[0], negm, 0, 0, 0);
                p0 = __builtin_amdgcn_mfma_f32_32x32x16_bf16(kf[2], q[1], p0, 0, 0, 0); p1 = __builtin_amdgcn_mfma_f32_32x32x16_bf16(kf[3], q[1], p1, 0, 0, 0);
#pragma unroll
                for (int d0 = 2; d0 < 4; ++d0) { kf[2 * d0] = *(LAS const bf16x8*)(kp_ + d0 * 2 * KCH); kf[2 * d0 + 1] = *(LAS const bf16x8*)(kp_ + d0 * 2 * KCH + 512); } }
            ATT_SB();
            if (doqk) {
#pragma unroll
                for (int d0 = 2; d0 < 4; ++d0) { p0 = __builtin_amdgcn_mfma_f32_32x32x16_bf16(kf[2 * d0], q[d0], p0, 0, 0, 0); p1 = __builtin_amdgcn_mfma_f32_32x32x16_bf16(kf[2 * d0 + 1], q[d0], p1, 0, 0, 0); } }
        } else {
            if (doqk) ATT_KLD(ko1);
            if (act) ATT_VLD(va, 0);
            ATT_SB();
            if (doqk) ATT_QKM();
        }
        if (act) {
            ATT_VLD(vb, 1); ATT_SB(); ATT_PVM(va, 0); ATT_SB();
            if (DV == 128) { ATT_VLD(va, 2); ATT_SB(); ATT_PVM(vb, 1); ATT_SB(); ATT_VLD(vb, 3); ATT_SB(); ATT_PVM(va, 2); ATT_SB(); ATT_PVM(vb, 3); }
            else ATT_PVM(vb, 1);
        }
        if constexpr (Side::ON) { if (sph == 3) { const SideTile T_ = side_tile(side, sg); side_consume(T_, shm, wid, lane); ++sg; } }
        ATT_SB();
        if (doqk) asm volatile("" : "+v"(p0), "+v"(p1));
        if (act) { asm volatile("" : "+v"(o[0]), "+v"(o[1])); if (DV == 128) asm volatile("" : "+v"(o[DV / 32 - 2]), "+v"(o[DV / 32 - 1])); }
        if constexpr (Side::ON) { if (sph <= 1) ATT_WAITV(4); else if (sph == 2) ATT_WAITV(2); else ATT_WAITV(3); }
        else ATT_WAIT_TILE();
        ATT_SB(); ATT_BAR(); ATT_SB();
        ko = ko1; vo = vo == 3 * VSLOT ? 0 : vo + VSLOT;
    }
    if (grp == 0) ATT_BAR();
#undef ATT_DMA
#undef ATT_KLD
#undef ATT_QKM
#undef ATT_VLD
#undef ATT_PVM
#undef ATT_WAIT_TILE
#undef ATT_CFOLD
}
__device__ __forceinline__ void load_q(bf16x8 (&q)[4], const bf16_t* Qrow0, int r32, int hi, int rsh = 0) {
#pragma unroll
    for (int d0 = 0; d0 < 4; ++d0) q[d0] = *(const bf16x8*)(Qrow0 + (unsigned)(((r32 * HW) << rsh) + d0 * 16 + hi * 8));
}
__device__ __forceinline__ void row_recip(float (&rl)[16], float lsum, LAS float* wsf, int r32, int hi) {
    const float lt = xhalf_sum(lsum);
    if (hi == 0) wsf[r32] = 1.0f / lt;
#pragma unroll
    for (int r = 0; r < 16; ++r) rl[r] = wsf[crow(r, hi)];
}
__device__ __forceinline__ int launder(int v) { asm volatile("" : "+v"(v)); return v; }
__device__ __forceinline__ float bperm_xor(float v, int lane, int off) { return __uint_as_float(__builtin_amdgcn_ds_bpermute((lane ^ off) << 2, __float_as_uint(v))); }
__device__ __forceinline__ bf16_t to_bf16(float v) { return (bf16_t)(cvt_pk_bf16(v, v) & 0xffffu); }

__device__ __forceinline__ void unit_gqa(LAS char* shm, const bf16_t* H, bf16_t* YB, int u, int tid_, int wid_, int lane_, int grp, const SideConv& side) {
    int tid = tid_; asm volatile("" : "+v"(tid)); const int lane = tid & 63; const int wid = __builtin_amdgcn_readfirstlane(tid >> 6); (void)wid_; (void)lane_;
    const int qb = u & 31, bh = u >> 5, h = bh % 6, b = bh / 6, r32 = lane & 31, hi = lane >> 5;
    const bf16_t* Hb = H + (size_t)b * SEQ * HW;
    const int q0 = qb * 256 + wid * 32;
    bf16x8 q[4]; load_q(q, Hb + (size_t)q0 * HW + C_QB + h * 64, r32, hi);
    float mhat = 0.f, lsum = 0.f; bool unset = true; f32x16 o[2]; o[0] = f32x16{}; o[1] = f32x16{};
    ModNone mod;
    attn_pass<64, ModNone, SideConv>(shm, Hb + C_KB + (h / 3) * 64, Hb + C_VB + (h / 3) * 64, 0, SEQ / 64, q, mod, mhat, lsum, unset, o, tid, wid, lane, grp, side);
    float rl[16]; row_recip(rl, lsum, (LAS float*)(shm + L_WS) + wid * 64, r32, hi);
    unsigned yo = (unsigned)(q0 + 4 * hi) * 384u + h * 64 + r32; asm volatile("" : "+v"(yo));
    bf16_t* Y = YB + (size_t)b * SEQ * 384 + yo;
#pragma unroll
    for (int r = 0; r < 16; ++r)
#pragma unroll
        for (int dq = 0; dq < 2; ++dq) Y[((r & 3) + 8 * (r >> 2)) * 384 + dq * 32] = to_bf16(o[dq][r] * rl[r]);
}
__device__ __forceinline__ void unit_na(LAS char* shm, const bf16_t* H, bf16_t* YA, const float* rpb_h  , int u, int tid_, int wid_, int lane_, int grp) {
    int tid = tid_; asm volatile("" : "+v"(tid)); const int lane = tid & 63; const int wid = __builtin_amdgcn_readfirstlane(tid >> 6); (void)wid_; (void)lane_;
    const int qb = u & 31, bh = u >> 5, h = bh % 6, b = bh / 6, r32 = lane & 31, hi = lane >> 5;
    LAS float* tab = (LAS float*)(shm + L_TAB);
    const bf16_t* Hb = H + (size_t)b * SEQ * HW;
    { int tlo_ = qb * 4 - 4; tlo_ = tlo_ < 0 ? 0 : (tlo_ > 120 ? 120 : tlo_); int thi_ = qb * 4 + 3 - 4; thi_ = thi_ < 0 ? 0 : (thi_ > 120 ? 120 : thi_); thi_ += 8;
      attn_pre<64>(shm, Hb + C_KA + h * 64, Hb + C_VA + h * 64, tlo_, thi_, wid, lane); }
    for (int i = tid; i < 15 * 128; i += 512) { const int dr = i >> 7, dc = (i & 127) - 63 + 15; tab[i] = (dc >= 0 && dc <= 30) ? rpb_h[h * 465 + dr * 31 + dc] * LOG2E : 0.f; }
    __syncthreads();
    const int q0 = qb * 256 + wid * 32;
    const int r = qb * 4 + (wid >> 1), c = (wid & 1) * 32 + r32;
    ModA mod; mod.tab = tab; mod.r = r; mod.cb = 63 - c + 4 * hi;
    { int rs = r - 4; rs = rs < 0 ? 0 : (rs > 120 ? 120 : rs); mod.rs = rs; int cs = c - 8; cs = cs < 0 ? 0 : (cs > 48 ? 48 : cs); mod.w = cs - 4 * hi; }
    int tlo = qb * 4 - 4; tlo = tlo < 0 ? 0 : (tlo > 120 ? 120 : tlo);
    int thi = qb * 4 + 3 - 4; thi = thi < 0 ? 0 : (thi > 120 ? 120 : thi); thi += 8;
    bf16x8 q[4]; load_q(q, Hb + (size_t)q0 * HW + C_QA + h * 64, r32, hi);
    float mhat = 0.f, lsum = 0.f; bool unset = true; f32x16 o[2]; o[0] = f32x16{}; o[1] = f32x16{};
    attn_pass<64, ModA, SideNone, true>(shm, Hb + C_KA + h * 64, Hb + C_VA + h * 64, tlo, thi, q, mod, mhat, lsum, unset, o, tid, wid, lane, grp);
    float rl[16]; row_recip(rl, lsum, (LAS float*)(shm + L_WS) + wid * 64, r32, hi);
    unsigned yo = (unsigned)(q0 + 4 * hi) * 384u + h * 64 + r32; asm volatile("" : "+v"(yo));
    bf16_t* Y = YA + (size_t)b * SEQ * 384 + yo;
#pragma unroll
    for (int rr = 0; rr < 16; ++rr)
#pragma unroll
        for (int dq = 0; dq < 2; ++dq) Y[((rr & 3) + 8 * (rr >> 2)) * 384 + dq * 32] = to_bf16(o[dq][rr] * rl[rr]);
}
template <int G_>
__device__ __forceinline__ void dil_sub_pass(LAS char* shm, const bf16_t* Hb, LAS float* tab, const float* t5, int j, int s, float& mhat, float& lsum, bool& unset, f32x16 (&o)[2], int tid, int wid, int lane, int grp) {
    constexpr int SH = 2 * G_, NAB = 32 >> SH, SL = SEQ >> SH;
    const int r32 = lane & 31, hi = lane >> 5, head = 2 * G_ + j;
    const int rho = s / NAB, ablk = (s % NAB) * 256, a0 = ablk + wid * 32;
    int lo = ablk - 64; lo = lo < 0 ? 0 : lo; int hi_k = ablk + 255 + 64; hi_k = hi_k > SL - 1 ? SL - 1 : hi_k;
    const bf16_t* Hs = Hb + (size_t)rho * HW;
    attn_pre<64>(shm, Hs + C_KC + head * 64, Hs + C_VC + head * 64, lo >> 6, (hi_k >> 6) + 1, wid, lane, SH);
    for (int i = tid; i < 384; i += 512) { const int jj = i - 192; tab[i] = (jj >= -64 && jj <= 64) ? t5[t5_bucket(jj << SH) * 10 + head] * LOG2E : 0.f; }
    __syncthreads();
    ModC<0> mod; mod.tc = tab; mod.q = a0 + r32; mod.qw0 = a0; mod.hi = hi;
    bf16x8 q[4]; load_q(q, Hs + ((size_t)a0 << SH) * HW + C_QC + head * 64, r32, hi, SH);
    attn_pass<64, ModC<0>, SideNone, true>(shm, Hs + C_KC + head * 64, Hs + C_VC + head * 64, lo >> 6, (hi_k >> 6) + 1, q, mod, mhat, lsum, unset, o, tid, wid, lane, grp, SideNone{}, SH);
}
template <int G_>
__device__ __forceinline__ void unit_dil_part(LAS char* shm, const bf16_t* H, bf16_t* YC, float* LSEP, const float* t5, int u, int tid_, int grp) {
    constexpr int SH = 2 * G_, NAB = 32 >> SH;
    int tid = tid_; asm volatile("" : "+v"(tid)); const int lane = tid & 63; const int wid = __builtin_amdgcn_readfirstlane(tid >> 6);
    const int s = u & 31, bj = u >> 5, j = bj & 1, b = bj >> 1, r32 = lane & 31, hi = lane >> 5;
    const bf16_t* Hb = H + (size_t)b * SEQ * HW;
    float mhat = 0.f, lsum = 0.f; bool unset = true; f32x16 o[2]; o[0] = f32x16{}; o[1] = f32x16{};
    dil_sub_pass<G_>(shm, Hb, (LAS float*)(shm + L_TAB), t5, j, s, mhat, lsum, unset, o, tid, wid, lane, grp);
    const int rho = s / NAB, a0 = (s % NAB) * 256 + wid * 32;
    LAS float* wsf = (LAS float*)(shm + L_WS) + wid * 64;
    const float lt = xhalf_sum(lsum);
    if (hi == 0) { wsf[r32] = 1.0f / lt; LSEP[((size_t)(G_ - 1) * MTOK + (size_t)b * SEQ + rho + ((a0 + r32) << SH)) * 2 + j] = mhat + __builtin_amdgcn_logf(lt); }
    LDS_WAIT();
    float rl[16];
#pragma unroll
    for (int r = 0; r < 16; ++r) rl[r] = wsf[crow(r, hi)];
    unsigned yo = (unsigned)(rho + ((a0 + 4 * hi) << SH)) * 256u + (G_ == 1 ? 128 : 0) + j * 64 + r32; asm volatile("" : "+v"(yo));
    bf16_t* Y = YC + (size_t)b * SEQ * 256 + yo;
#pragma unroll
    for (int rr = 0; rr < 16; ++rr)
#pragma unroll
        for (int dq = 0; dq < 2; ++dq) Y[(((rr & 3) + 8 * (rr >> 2)) << SH) * 256 + dq * 32] = to_bf16(o[dq][rr] * rl[rr]);
}
__device__ __forceinline__ void unit_dil(LAS char* shm, const bf16_t* H, bf16_t* YC, const float* LSEP, const float* t5, int u, int tid_, int wid_, int lane_, int grp) {
    int tid = tid_; asm volatile("" : "+v"(tid)); const int lane = tid & 63; const int wid = __builtin_amdgcn_readfirstlane(tid >> 6); (void)wid_; (void)lane_;
    const int qb = u & 31, bj = u >> 5, j = bj & 1, b = bj >> 1, r32 = lane & 31, hi = lane >> 5;
    const bf16_t* Hb = H + (size_t)b * SEQ * HW;
    const int q0 = qb * 256 + wid * 32;
    float mhat = 0.f, lsum = 0.f; bool unset = true; f32x16 o[2]; o[0] = f32x16{}; o[1] = f32x16{};
    dil_sub_pass<0>(shm, Hb, (LAS float*)(shm + L_TAB), t5, j, qb, mhat, lsum, unset, o, tid, wid, lane, grp);
    LAS float* wsf = (LAS float*)(shm + L_WS) + wid * 64;
    const float lt = xhalf_sum(lsum);
    float w1 = 0.f, w2 = 0.f;
    if (hi == 0) { const size_t tk = ((size_t)b * SEQ + q0 + r32) * 2 + j;
        const float l0 = mhat + __builtin_amdgcn_logf(lt), l1 = LSEP[tk], l2 = LSEP[(size_t)MTOK * 2 + tk];
        const float mx = __builtin_fmaxf(__builtin_fmaxf(l0, l1), l2);
        const float e0 = __builtin_amdgcn_exp2f(l0 - mx), e1 = __builtin_amdgcn_exp2f(l1 - mx), e2 = __builtin_amdgcn_exp2f(l2 - mx);
        const float inv = 1.0f / (e0 + e1 + e2);
        wsf[r32] = e0 * inv / lt; w1 = e1 * inv; w2 = e2 * inv; }
    LDS_WAIT();
    float c0[16], c1[16], c2[16];
#pragma unroll
    for (int r = 0; r < 16; ++r) c0[r] = wsf[crow(r, hi)];
    LDS_WAIT();
    if (hi == 0) { wsf[r32] = w1; wsf[32 + r32] = w2; }
    LDS_WAIT();
#pragma unroll
    for (int r = 0; r < 16; ++r) { c1[r] = wsf[crow(r, hi)]; c2[r] = wsf[32 + crow(r, hi)]; }
    unsigned yo = (unsigned)(q0 + 4 * hi) * 256u + j * 64 + r32; asm volatile("" : "+v"(yo));
    bf16_t* Y = YC + (size_t)b * SEQ * 256 + yo;
#pragma unroll
    for (int rr = 0; rr < 16; ++rr)
#pragma unroll
        for (int dq = 0; dq < 2; ++dq) { bf16_t* yp = Y + ((rr & 3) + 8 * (rr >> 2)) * 256 + dq * 32;
            const float p2 = __uint_as_float((unsigned)yp[0] << 16), p1 = __uint_as_float((unsigned)yp[128] << 16);
            yp[0] = to_bf16(o[dq][rr] * c0[rr] + c1[rr] * p1 + c2[rr] * p2); yp[128] = 0; }
}
template <int PASS> __device__ __forceinline__ void unit_diff(LAS char* shm, const bf16_t* H, bf16_t* YD, const float* t5, const float* lam_p  , const float* gain  , float lam_init, float* stash  , int u, int tid_, int wid_, int lane_, int grp) {
    int tid = tid_; asm volatile("" : "+v"(tid)); const int lane = tid & 63; const int wid = __builtin_amdgcn_readfirstlane(tid >> 6); (void)wid_; (void)lane_;
    const int qb = u & 31, bh = u >> 5, h = bh & 3, b = bh >> 2, r32 = lane & 31, hi = lane >> 5;
    LAS float* tab = (LAS float*)(shm + L_TAB);
    attn_pre<128>(shm, H + (size_t)b * SEQ * HW + C_KD + h * 128 + PASS * 64, H + (size_t)b * SEQ * HW + C_VD + h * 128, 0, SEQ / 64, wid, lane);
    for (int i = tid; i < 2049; i += 512) tab[i] = t5[t5_bucket(i - 1024) * 10 + 6 + h] * LOG2E;
    __syncthreads();
    const float lam = __expf(wave_sum(lam_p[lane] * lam_p[64 + lane])) - __expf(wave_sum(lam_p[128 + lane] * lam_p[192 + lane])) + lam_init;
    const bf16_t* Hb = H + (size_t)b * SEQ * HW;
    const int q0 = qb * 256 + wid * 32;
    ModD mod; mod.tb = tab; mod.q = q0 + r32; mod.qw0 = q0; mod.hi = hi; mod.cneg = __uint_as_float(__builtin_amdgcn_readfirstlane(__float_as_uint(tab[0]))); mod.cpos = __uint_as_float(__builtin_amdgcn_readfirstlane(__float_as_uint(tab[2048])));
    f32x16 o[4];
    { constexpr int pass = PASS;
        bf16x8 q[4]; load_q(q, Hb + (size_t)q0 * HW + C_QD + h * 128 + pass * 64, r32, hi);
        float mhat = 0.f, lsum = 0.f; bool unset = true;
#pragma unroll
        for (int dq = 0; dq < 4; ++dq) o[dq] = f32x16{};
        attn_pass<128, ModD, SideNone, true>(shm, Hb + C_KD + h * 128 + pass * 64, Hb + C_VD + h * 128, 0, SEQ / 64, q, mod, mhat, lsum, unset, o, tid, wid, lane, grp);
        float rl[16]; row_recip(rl, lsum, (LAS float*)(shm + L_WS) + wid * 64, r32, hi);
        const int lane2 = launder(lane);
        unsigned so = (unsigned)tid; asm volatile("" : "+v"(so));
        f32x4* st4 = (f32x4*)stash + so;
        if (pass == 0) {
#pragma unroll
            for (int dq = 0; dq < 4; ++dq)
#pragma unroll
                for (int r4 = 0; r4 < 4; ++r4) st4[(dq * 4 + r4) * 512] = (f32x4){o[dq][4 * r4] * rl[4 * r4], o[dq][4 * r4 + 1] * rl[4 * r4 + 1], o[dq][4 * r4 + 2] * rl[4 * r4 + 2], o[dq][4 * r4 + 3] * rl[4 * r4 + 3]};
        } else {
            float ss[16];
#pragma unroll
            for (int r = 0; r < 16; ++r) ss[r] = 0.f;
#pragma unroll
            for (int dq = 0; dq < 4; ++dq) {
                f32x4 s1[4];
#pragma unroll
                for (int r4 = 0; r4 < 4; ++r4) s1[r4] = st4[(dq * 4 + r4) * 512];
                asm volatile("" ::: "memory");
#pragma unroll
                for (int r4 = 0; r4 < 4; ++r4)
#pragma unroll
                    for (int k = 0; k < 4; ++k) { const int r = 4 * r4 + k; const float v = s1[r4][k] - lam * (o[dq][r] * rl[r]); o[dq][r] = v; ss[r] += v * v; }
                asm volatile("" ::: "memory"); }
#pragma unroll
            for (int r = 0; r < 16; ++r) {
#pragma unroll
                for (int off = 1; off < 32; off <<= 1) ss[r] += bperm_xor(ss[r], lane2, off);
                ss[r] = rsqrtf(ss[r] * (1.0f / 128.0f) + 1e-6f) * (1.0f - lam_init);
            }
            unsigned yo = (unsigned)(q0 + 4 * hi) * 512u + h * 128 + r32; asm volatile("" : "+v"(yo));
            bf16_t* Y = YD + (size_t)b * SEQ * 512 + yo;
#pragma unroll
            for (int dq = 0; dq < 4; ++dq) { const float gn = gain[dq * 32 + r32];
#pragma unroll
                for (int r = 0; r < 16; ++r) Y[((r & 3) + 8 * (r >> 2)) * 512 + dq * 32] = to_bf16(o[dq][r] * ss[r] * gn); }
        }
    }
}
}

__device__ __forceinline__ void conv_item(const float* W, int srcN, int k0, int n0, bf16_t* WT, int dst_ld, int dst_row0, float scale, LAS float* scr, int lane) {
    float wv[32];
    const float* wp = W + (size_t)(k0 + (lane >> 5)) * srcN + n0 + (lane & 31);
#pragma unroll
    for (int i = 0; i < 32; ++i) wv[i] = __builtin_nontemporal_load(wp + (size_t)(2 * i) * srcN);
    asm volatile("" ::: "memory");
#pragma unroll
    for (int i = 0; i < 32; ++i) scr[(2 * i + (lane >> 5)) * 33 + (lane & 31)] = wv[i];
    LDS_WAIT(); asm volatile("" ::: "memory");
    const int c = lane & 7;
#pragma unroll
    for (int j = 0; j < 4; ++j) { const int n = (lane >> 3) + 8 * j; const LAS float* s = scr + (8 * c) * 33 + n;
        u32x4 o; o.x = cvt_pk_bf16(s[0 * 33] * scale, s[1 * 33] * scale); o.y = cvt_pk_bf16(s[2 * 33] * scale, s[3 * 33] * scale); o.z = cvt_pk_bf16(s[4 * 33] * scale, s[5 * 33] * scale); o.w = cvt_pk_bf16(s[6 * 33] * scale, s[7 * 33] * scale);
        *(u32x4*)(WT + (size_t)(dst_row0 + n) * dst_ld + k0 + 8 * c) = o; }
    LDS_WAIT(); asm volatile("" ::: "memory");
}

struct Ptrs {
    const float* x; const float* p; const float* w_in; const float* w_na; const float* w_gqa; const float* w_dil; const float* w_diff; const float* w_out;
    const float* rpb; const float* qk_gain; const float* lam; const float* diff_gain; const float* t5; const float* w_router;
    const float* w_eg; const float* w_eu; const float* w_ed; const float* w_pp; const float* w_pg; const float* ln_g; const float* ln_b;
    float* out; unsigned char* ws;
};

__device__ __forceinline__ void phase_convert(const Ptrs& P, int L, LAS unsigned char* lds, int gw, int NGW, int lane, int wave) {
    unsigned char* ws = P.ws;
    LAS float* scr = (LAS float*)(lds + wave * 16384);
    bf16_t* WIN = (bf16_t*)(ws + WS_WIN); bf16_t* WG = (bf16_t*)(ws + WS_WG);
    constexpr int J1 = 16 * 140, J2 = 16 * 128, J3 = 6 * 32, J4 = 6 * 32, J5 = 2 * 32, J6 = 8 * 32, J7 = 16 * 32, J8 = 16 * 32, J9 = 4 * 32;
    constexpr int NITEMS = J1 + J2 + J3 + J4 + J5 + J6 + J7 + J8 + J9;
    const float* w_in = P.w_in + (size_t)L * DM * INW;
    for (int it = gw; it < NITEMS; it += NGW) {
        int r = it;
        if (r < J1) { const int kb = r / 140, nb = r % 140, n0 = nb * 32; const bool isq = (n0 < 384) || (n0 >= C_QC && n0 < C_KC) || (n0 >= C_QD && n0 < C_KD);
            conv_item(w_in, INW, kb * 64, n0, WIN, DM, n0, isq ? QSCALE : 1.0f, scr, lane); continue; } r -= J1;
        if (r < J2) { const int kb = r / 128, nb = r % 128; conv_item(w_in, INW, kb * 64, C_HEND + nb * 32, WG, DM, nb * 32, 1.0f, scr, lane); continue; } r -= J2;
        if (r < J3) { const int kb = r / 32, nb = r % 32; conv_item(P.w_na + (size_t)L * 384 * DM, DM, kb * 64, nb * 32, (bf16_t*)(ws + WS_WNA), 384, nb * 32, 1.0f, scr, lane); continue; } r -= J3;
        if (r < J4) { const int kb = r / 32, nb = r % 32; conv_item(P.w_gqa + (size_t)L * 384 * DM, DM, kb * 64, nb * 32, (bf16_t*)(ws + WS_WGQA), 384, nb * 32, 1.0f, scr, lane); continue; } r -= J4;
        if (r < J5) { const int kb = r / 32, nb = r % 32; conv_item(P.w_dil + (size_t)L * 128 * DM, DM, kb * 64, nb * 32, (bf16_t*)(ws + WS_WDIL), 256, nb * 32, 1.0f, scr, lane); continue; } r -= J5;
        if (r < J6) { const int kb = r / 32, nb = r % 32; conv_item(P.w_diff + (size_t)L * 512 * DM, DM, kb * 64, nb * 32, (bf16_t*)(ws + WS_WDIFF), 512, nb * 32, 1.0f, scr, lane); continue; } r -= J6;
        if (r < J7) { const int kb = r / 32, nb = r % 32; conv_item(P.w_out + (size_t)L * DM * DM, DM, kb * 64, nb * 32, (bf16_t*)(ws + WS_WO), DM, nb * 32, 1.0f, scr, lane); continue; } r -= J7;
        if (r < J8) { const int kb = r / 32, nb = r % 32; conv_item(P.w_pg + (size_t)L * DM * DM, DM, kb * 64, nb * 32, (bf16_t*)(ws + WS_WPG), DM, nb * 32, 1.0f, scr, lane); continue; } r -= J8;
        if (r < J9) { const int kb = r / 32, nb = r % 32; conv_item(P.w_pp + (size_t)L * PLE * DM, DM, kb * 64, nb * 32, (bf16_t*)(ws + WS_WPP), PLE, nb * 32, 1.0f, scr, lane); continue; } r -= J9;
    }
    { const int gt = gw * 64 + lane, NT = NGW * 64;
      for (int i = gt; i < 1024 * 16; i += NT) { const int row = i >> 4, ch = i & 15; *(u32x4*)((bf16_t*)(ws + WS_WDIL) + (size_t)row * 256 + 128 + ch * 8) = (u32x4){0u, 0u, 0u, 0u}; }
      const f32x4* ps = (const f32x4*)(P.p + (size_t)L * MTOK * PLE); u32x2* pd = (u32x2*)(ws + WS_PB);
      static_assert((MTOK * PLE / 4) % (8 * 256 * 512) == 0 && (MTOK * DM / 4) % (8 * 256 * 512) == 0, "conversion loops are unrolled by 8 over a 256 x 512 grid");
      for (int i = gt; i < MTOK * PLE / 4; i += 8 * NT) { f32x4 v[8];
#pragma unroll
          for (int k = 0; k < 8; ++k) v[k] = __builtin_nontemporal_load(ps + i + k * NT);
          asm volatile("" ::: "memory");
#pragma unroll
          for (int k = 0; k < 8; ++k) { u32x2 o; o.x = cvt_pk_bf16(v[k][0], v[k][1]); o.y = cvt_pk_bf16(v[k][2], v[k][3]); pd[i + k * NT] = o; } }
      if (L == 0) { const f32x4* xs = (const f32x4*)P.x; u32x2* xd = (u32x2*)(ws + WS_XB);
          for (int i = gt; i < MTOK * DM / 4; i += 8 * NT) { f32x4 v[8];
#pragma unroll
              for (int k = 0; k < 8; ++k) v[k] = __builtin_nontemporal_load(xs + i + k * NT);
              asm volatile("" ::: "memory");
#pragma unroll
              for (int k = 0; k < 8; ++k) { u32x2 o; o.x = cvt_pk_bf16(v[k][0], v[k][1]); o.y = cvt_pk_bf16(v[k][2], v[k][3]); xd[i + k * NT] = o; } } }
    }
}

__device__ __forceinline__ void phase_qknorm(const Ptrs& P, int L, int gw, int NGW, int lane) {
    bf16_t* H = (bf16_t*)(P.ws + WS_H);
    const int head = lane >> 3, j = lane & 7;
    const float* gain = P.qk_gain + (size_t)L * 128 + (head < 6 ? 0 : 64) + j * 8;
    float g[8];
#pragma unroll
    for (int e = 0; e < 8; ++e) g[e] = gain[e];
    float fr[8];
#pragma unroll
    for (int e = 0; e < 8; ++e) fr[e] = __builtin_amdgcn_exp2f(-(float)((j & 1) * 8 + e) * (13.287712379549449f / 16.0f));
    const float osc = head < 6 ? QSCALE : 1.0f;
    for (int m0 = gw; m0 < MTOK; m0 += 4 * NGW) {
        u32x4 raw[4];
#pragma unroll
        for (int k = 0; k < 4; ++k) raw[k] = *(const u32x4*)(H + (size_t)(m0 + k * NGW) * HW + C_QB + lane * 8);
        asm volatile("" ::: "memory");
#pragma unroll
        for (int k = 0; k < 4; ++k) {
            const int m = m0 + k * NGW;
            bf16_t* hp = H + (size_t)m * HW + C_QB + lane * 8;
            const u32x4 w = raw[k];
            float v[8] = {bf_lo(w.x), bf_hi(w.x), bf_lo(w.y), bf_hi(w.y), bf_lo(w.z), bf_hi(w.z), bf_lo(w.w), bf_hi(w.w)};
            float ss = 0.f;
#pragma unroll
            for (int e = 0; e < 8; ++e) ss += v[e] * v[e];
            ss += __shfl_xor(ss, 1); ss += __shfl_xor(ss, 2); ss += __shfl_xor(ss, 4);
            const float rs = rsqrtf(ss * (1.0f / 64.0f) + 1e-6f);
            const int tpos = m & (SEQ - 1); const float pos = (float)((j < 4) ? (tpos >> 6) : (tpos & 63));
            float o[8];
#pragma unroll
            for (int e = 0; e < 8; ++e) {
                const float y = v[e] * rs * g[e];
                const float yo = __shfl_xor(y, 2);
                float rev = pos * fr[e] * 0.15915494309189535f; rev -= floorf(rev);
                const float sn = __builtin_amdgcn_sinf(rev), cs = __builtin_amdgcn_cosf(rev);
                o[e] = ((j & 2) == 0) ? (y * cs - yo * sn) : (y * cs + yo * sn);
                o[e] *= osc;
            }
            u32x4 ow; ow.x = cvt_pk_bf16(o[0], o[1]); ow.y = cvt_pk_bf16(o[2], o[3]); ow.z = cvt_pk_bf16(o[4], o[5]); ow.w = cvt_pk_bf16(o[6], o[7]);
            *(u32x4*)hp = ow;
        }
    }
}

__device__ __forceinline__ void ln_row(f32x4 (&v)[4], const float* g, const float* b, int lane) {
    float s = 0.f;
#pragma unroll
    for (int j = 0; j < 4; ++j) s += (v[j][0] + v[j][1]) + (v[j][2] + v[j][3]);
    const float mean = wave_sum(s) * (1.0f / DM); float s2 = 0.f;
#pragma unroll
    for (int j = 0; j < 4; ++j) { v[j] = v[j] - mean; s2 += (v[j][0] * v[j][0] + v[j][1] * v[j][1]) + (v[j][2] * v[j][2] + v[j][3] * v[j][3]); }
    const float rstd = rsqrtf(wave_sum(s2) * (1.0f / DM) + LN_EPS);
#pragma unroll
    for (int j = 0; j < 4; ++j) { const f32x4 gg = *(const f32x4*)(g + 256 * j + 4 * lane), bb = *(const f32x4*)(b + 256 * j + 4 * lane); v[j] = v[j] * rstd * gg + bb; }
}
__device__ __forceinline__ void load_row_bf16(f32x4 (&v)[4], const bf16_t* zr, int lane, float scale) {
#pragma unroll
    for (int j = 0; j < 4; ++j) { const u32x2 w = *(const u32x2*)(zr + 256 * j + 4 * lane); v[j] = (f32x4){bf_lo(w.x) * scale, bf_hi(w.x) * scale, bf_lo(w.y) * scale, bf_hi(w.y) * scale}; }
}
__device__ __forceinline__ void store_row_bf16(const f32x4 (&v)[4], bf16_t* xb, int lane) {
#pragma unroll
    for (int j = 0; j < 4; ++j) { u32x2 o; o.x = cvt_pk_bf16(v[j][0], v[j][1]); o.y = cvt_pk_bf16(v[j][2], v[j][3]); *(u32x2*)(xb + 256 * j + 4 * lane) = o; }
}
__device__ __forceinline__ void store_row_f32(const f32x4 (&v)[4], float* xo, int lane) {
#pragma unroll
    for (int j = 0; j < 4; ++j) __builtin_nontemporal_store(v[j], (f32x4*)(xo + 256 * j + 4 * lane));
}

__device__ __forceinline__ void phase_ln1_router(const Ptrs& P, int L, const bf16_t* Z, LAS unsigned char* lds, int gw, int NGW, int lane, int tid) {
    LAS float* wT = (LAS float*)lds;
    const float* wr = P.w_router + (size_t)L * DM * NEXP;
    { f32x4 wv[8];
#pragma unroll
      for (int q = 0; q < 8; ++q) wv[q] = ((const f32x4*)wr)[tid + 512 * q];
      asm volatile("" ::: "memory");
#pragma unroll
      for (int q = 0; q < 8; ++q) { const int i = 4 * (tid + 512 * q), k = i >> 4, e0 = i & 15;
#pragma unroll
          for (int c = 0; c < 4; ++c) wT[(e0 + c) * DM + k] = wv[q][c]; } }
    __syncthreads();
    bf16_t* XB = (bf16_t*)(P.ws + WS_XB); float* AFF = (float*)(P.ws + WS_AFF);
    const float* g = P.ln_g + (size_t)(L * 3 + 0) * DM; const float* b = P.ln_b + (size_t)(L * 3 + 0) * DM;
    for (int m0 = gw; m0 < MTOK; m0 += 4 * NGW) {
      u32x2 raw[4][4];
#pragma unroll
      for (int k = 0; k < 4; ++k)
#pragma unroll
          for (int j = 0; j < 4; ++j) raw[k][j] = *(const u32x2*)(Z + (size_t)(m0 + k * NGW) * DM + 256 * j + 4 * lane);
      asm volatile("" ::: "memory");
#pragma unroll
      for (int k = 0; k < 4; ++k) {
        const int m = m0 + k * NGW;
        f32x4 v[4];
#pragma unroll
        for (int j = 0; j < 4; ++j) v[j] = (f32x4){bf_lo(raw[k][j].x), bf_hi(raw[k][j].x), bf_lo(raw[k][j].y), bf_hi(raw[k][j].y)};
        ln_row(v, g, b, lane);
        store_row_bf16(v, XB + (size_t)m * DM, lane);
        float a16[16];
        const LAS float* wl = wT + 4 * lane; asm volatile("" : "+v"(wl));
#pragma unroll
        for (int e = 0; e < 16; ++e) { float a = 0.f;
#pragma unroll
            for (int j = 0; j < 4; ++j) { const f32x4 w = *(const LAS f32x4*)(wl + e * DM + 256 * j); a += (v[j][0] * w[0] + v[j][1] * w[1]) + (v[j][2] * w[2] + v[j][3] * w[3]); }
            a16[e] = a; }
        float a8[8], a4[4], a2[2], a1;
#pragma unroll
        for (int i = 0; i < 8; ++i) { const bool up = (lane & 32) != 0; const float send = up ? a16[i] : a16[8 + i], keep = up ? a16[8 + i] : a16[i]; a8[i] = keep + __shfl_xor(send, 32); }
#pragma unroll
        for (int i = 0; i < 4; ++i) { const bool up = (lane & 16) != 0; const float send = up ? a8[i] : a8[4 + i], keep = up ? a8[4 + i] : a8[i]; a4[i] = keep + __shfl_xor(send, 16); }
#pragma unroll
        for (int i = 0; i < 2; ++i) { const bool up = (lane & 8) != 0; const float send = up ? a4[i] : a4[2 + i], keep = up ? a4[2 + i] : a4[i]; a2[i] = keep + __shfl_xor(send, 8); }
        { const bool up = (lane & 4) != 0; const float send = up ? a2[0] : a2[1], keep = up ? a2[1] : a2[0]; a1 = keep + __shfl_xor(send, 4); }
        a1 += __shfl_xor(a1, 2); a1 += __shfl_xor(a1, 1);
        float mx = a1;
        mx = fmaxf(mx, __shfl_xor(mx, 4)); mx = fmaxf(mx, __shfl_xor(mx, 8)); mx = fmaxf(mx, __shfl_xor(mx, 16)); mx = fmaxf(mx, __shfl_xor(mx, 32));
        const float ex_ = __expf(a1 - mx);
        float den = ex_;
        den += __shfl_xor(den, 4); den += __shfl_xor(den, 8); den += __shfl_xor(den, 16); den += __shfl_xor(den, 32);
        const int myexp = 8 * (lane >> 5) + 4 * ((lane >> 4) & 1) + 2 * ((lane >> 3) & 1) + ((lane >> 2) & 1);
        const float mine = ex_; const int lane_e = myexp;
        if ((lane & 3) == 0) AFF[((size_t)(m >> 13) * NEXP + lane_e) * SEQ + (m & (SEQ - 1))] = mine / den;
      }
    }
}

__device__ __forceinline__ void phase_topk(const Ptrs& P, LAS unsigned char* lds, int blk, int G, int tid, int lane, int wave) {
    LAS unsigned* hist = (LAS unsigned*)lds;
    LAS unsigned* ctl = hist + 256;
    LAS unsigned* wtot = hist + 320;
    const float* AFF = (const float*)(P.ws + WS_AFF); int* SLOT = (int*)(P.ws + WS_SLOT); int* IDX = (int*)(P.ws + WS_IDX); float* GATEV = (float*)(P.ws + WS_GATEV);
    LAS int* lst = (LAS int*)(hist + 384);
    const bf16_t* XB = (const bf16_t*)(P.ws + WS_XB); bf16_t* XIN = (bf16_t*)(P.ws + WS_XIN);
    for (int it4 = blk; it4 < 4 * NB * NEXP; it4 += G) {
        const int item = it4 >> 2, part = it4 & 3;
        const int b = item >> 4, e = item & 15;
        const u32x4* src = (const u32x4*)(AFF + (size_t)item * SEQ) + tid * 4;
        unsigned key[16];
#pragma unroll
        for (int j = 0; j < 4; ++j) { const u32x4 w = src[j]; key[4 * j] = w.x; key[4 * j + 1] = w.y; key[4 * j + 2] = w.z; key[4 * j + 3] = w.w; }
        unsigned prefix = 0u, mask = 0u, need = CAP;
#pragma unroll 1
        for (int pass = 0; pass < 4; ++pass) {
            const int shift = 24 - 8 * pass;
            if (tid < 256) hist[tid] = 0u;
            __syncthreads();
#pragma unroll
            for (int j = 0; j < 16; ++j) if ((key[j] & mask) == prefix) __hip_atomic_fetch_add(&hist[(key[j] >> shift) & 255u], 1u, __ATOMIC_RELAXED, __HIP_MEMORY_SCOPE_WORKGROUP);
            __syncthreads();
            if (wave == 0) {
                unsigned c[4]; unsigned s = 0u;
#pragma unroll
                for (int j = 0; j < 4; ++j) { c[j] = hist[255 - (4 * lane + j)]; s += c[j]; }
                unsigned incl = s;
#pragma unroll
                for (int o = 1; o < 64; o <<= 1) { const unsigned t = __shfl_up(incl, o); if (lane >= o) incl += t; }
                const unsigned excl = incl - s;
                if (excl < need && need <= incl) {
                    unsigned run = excl; unsigned bin = 0u, nn = 0u; bool found = false;
#pragma unroll
                    for (int j = 0; j < 4; ++j) { if (!found && run + c[j] >= need) { bin = 255u - (unsigned)(4 * lane + j); nn = need - run; found = true; } run += c[j]; }
                    ctl[0] = bin; ctl[1] = nn;
                }
            }
            __syncthreads();
            prefix |= ctl[0] << shift; mask |= 0xFFu << shift; need = ctl[1];
            __syncthreads();
        }
        unsigned gt = 0u, eq = 0u;
#pragma unroll
        for (int j = 0; j < 16; ++j) { gt += key[j] > prefix ? 1u : 0u; eq += key[j] == prefix ? 1u : 0u; }
        const unsigned mine = gt | (eq << 16);
        unsigned incl = mine;
#pragma unroll
        for (int o = 1; o < 64; o <<= 1) { const unsigned t = __shfl_up(incl, o); if (lane >= o) incl += t; }
        if (lane == 63) wtot[wave] = incl;
        __syncthreads();
        unsigned base = 0u;
#pragma unroll
        for (int w = 0; w < 8; ++w) base += (w < wave) ? wtot[w] : 0u;
        unsigned run = base + incl - mine;
        unsigned gtb = run & 0xffffu, eqb = run >> 16;
        int* slot = SLOT + ((size_t)b * SEQ) * NEXP + e;
#pragma unroll
        for (int j = 0; j < 16; ++j) {
            const int s = tid * 16 + j; const unsigned k = key[j];
            const bool isgt = k > prefix, iseq = k == prefix;
            const bool sel = isgt || (iseq && eqb < need);
            const unsigned pos = gtb + (eqb < need ? eqb : need);
            if (sel && (int)(pos >> 8) == part) { IDX[(size_t)(e * NB + b) * CAP + pos] = b * SEQ + s; GATEV[(size_t)(e * NB + b) * CAP + pos] = __uint_as_float(k); }
            if ((tid >> 7) == part) slot[(size_t)s * NEXP] = sel ? (int)pos : -1;
            gtb += isgt ? 1u : 0u; eqb += iseq ? 1u : 0u;
        }
        __syncthreads();
        __syncthreads();
    }
}

__device__ __forceinline__ void phase_gather(const Ptrs& P, int gw, int NGW, int lane) {
    const bf16_t* XB = (const bf16_t*)(P.ws + WS_XB); bf16_t* XIN = (bf16_t*)(P.ws + WS_XIN); const int* IDX = (const int*)(P.ws + WS_IDX);
    for (int r0 = gw; r0 < NB * NEXP * CAP; r0 += 4 * NGW) {
        int sidx[4];
#pragma unroll
        for (int k = 0; k < 4; ++k) { const int r = r0 + k * NGW; const int c = r & (CAP - 1), eb = r >> 10, b = eb & 3, e = eb >> 2; sidx[k] = b * SEQ + IDX[(b * NEXP + e) * CAP + c]; }
        u32x4 v0[4], v1[4];
#pragma unroll
        for (int k = 0; k < 4; ++k) { const u32x4* src = (const u32x4*)(XB + (size_t)sidx[k] * DM); v0[k] = src[lane]; v1[k] = src[64 + lane]; }
        asm volatile("" ::: "memory");
#pragma unroll
        for (int k = 0; k < 4; ++k) { u32x4* dst = (u32x4*)(XIN + (size_t)(r0 + k * NGW) * DM); dst[lane] = v0[k]; dst[64 + lane] = v1[k]; }
    }
}

__device__ __forceinline__ void phase_ln2(const Ptrs& P, int L, int gw, int NGW, int lane) {
    const bf16_t* YO = (const bf16_t*)(P.ws + WS_XIN); const int* SLOT = (const int*)(P.ws + WS_SLOT); bf16_t* XB = (bf16_t*)(P.ws + WS_XB);
    const float* g = P.ln_g + (size_t)(L * 3 + 1) * DM; const float* bb = P.ln_b + (size_t)(L * 3 + 1) * DM;
    for (int m0 = gw; m0 < MTOK; m0 += 2 * NGW) {
        const int m1 = m0 + NGW;
        f32x4 v0[4], v1[4]; load_row_bf16(v0, XB + (size_t)m0 * DM, lane, ALPHA); load_row_bf16(v1, XB + (size_t)m1 * DM, lane, ALPHA);
        const int s0 = SLOT[(size_t)m0 * NEXP + (lane & 15)], s1 = SLOT[(size_t)m1 * NEXP + (lane & 15)];
        unsigned bm = (unsigned)(__ballot(s0 >= 0) & 0xffffull) | ((unsigned)(__ballot(s1 >= 0) & 0xffffull) << 16);
        const int sl = (lane & 16) ? s1 : s0;
        while (bm) {
            int id[4]; bool ok[4]; u32x2 w[4][4];
#pragma unroll
            for (int q = 0; q < 4; ++q) { ok[q] = bm != 0u; id[q] = ok[q] ? __builtin_ctz(bm) : 0; bm = ok[q] ? (bm & (bm - 1u)) : 0u; }
#pragma unroll
            for (int q = 0; q < 4; ++q) if (ok[q]) {
                const int c = __shfl(sl, id[q]), e = id[q] & 15, b = ((id[q] >> 4) ? m1 : m0) >> 13;
                const bf16_t* yr = YO + (size_t)((e * NB + b) * CAP + c) * DM;
#pragma unroll
                for (int j = 0; j < 4; ++j) w[q][j] = *(const u32x2*)(yr + 256 * j + 4 * lane); }
#pragma unroll
            for (int q = 0; q < 4; ++q) if (ok[q]) {
                if (id[q] >> 4) {
#pragma unroll
                    for (int j = 0; j < 4; ++j) { v1[j][0] += bf_lo(w[q][j].x); v1[j][1] += bf_hi(w[q][j].x); v1[j][2] += bf_lo(w[q][j].y); v1[j][3] += bf_hi(w[q][j].y); }
                } else {
#pragma unroll
                    for (int j = 0; j < 4; ++j) { v0[j][0] += bf_lo(w[q][j].x); v0[j][1] += bf_hi(w[q][j].x); v0[j][2] += bf_lo(w[q][j].y); v0[j][3] += bf_hi(w[q][j].y); }
                } }
        }
        ln_row(v0, g, bb, lane); store_row_bf16(v0, XB + (size_t)m0 * DM, lane);
        ln_row(v1, g, bb, lane); store_row_bf16(v1, XB + (size_t)m1 * DM, lane);
    }
}

__device__ __forceinline__ void phase_ln3(const Ptrs& P, int L, const bf16_t* Z, float* XO, int gw, int NGW, int lane) {
    bf16_t* XB = (bf16_t*)(P.ws + WS_XB);
    const float* g = P.ln_g + (size_t)(L * 3 + 2) * DM; const float* bb = P.ln_b + (size_t)(L * 3 + 2) * DM;
    for (int m0 = gw; m0 < MTOK; m0 += 4 * NGW) {
        u32x2 raw[4][4];
#pragma unroll
        for (int k = 0; k < 4; ++k)
#pragma unroll
            for (int j = 0; j < 4; ++j) raw[k][j] = *(const u32x2*)(Z + (size_t)(m0 + k * NGW) * DM + 256 * j + 4 * lane);
        asm volatile("" ::: "memory");
#pragma unroll
        for (int k = 0; k < 4; ++k) {
            const int m = m0 + k * NGW;
            f32x4 v[4];
#pragma unroll
            for (int j = 0; j < 4; ++j) v[j] = (f32x4){bf_lo(raw[k][j].x), bf_hi(raw[k][j].x), bf_lo(raw[k][j].y), bf_hi(raw[k][j].y)};
            ln_row(v, g, bb, lane);
            if (L == DEPTH - 1) store_row_f32(v, XO + (size_t)m * DM, lane); else store_row_bf16(v, XB + (size_t)m * DM, lane);
        }
    }
}

constexpr int NPH = 14;
struct Args { Ptrs P; int ph_lo, ph_hi, li, pad; };
__global__ void __launch_bounds__(512, 2) mega_fwd(Args args) {
    extern __shared__ __attribute__((aligned(16))) unsigned char lds_raw[];
    LAS unsigned char* lds = (LAS unsigned char*)lds_raw;
    const int tid0 = threadIdx.x;
    const int G = gridDim.x, bx0 = blockIdx.x, NGW = G * 8;
    volatile LAS unsigned* MISC = (volatile LAS unsigned*)(lds + MISC_OFF);
    for (int u = tid0; u < 32; u += 512) MISC[u] = 0u;
#define LAYER_PTRS const bf16_t* xprev = (const bf16_t*)(ws + WS_XB); bf16_t* Za = (bf16_t*)(ws + WS_Z1); bf16_t* Zb = (bf16_t*)(ws + WS_XB); bf16_t* Zc = Za; \
    float* Xo = P.out; const char* XBc = (const char*)(ws + WS_XB); (void)xprev; (void)Zb; (void)Zc; (void)Xo; (void)XBc; (void)Za;
#define PHASE_IDS const __attribute__((address_space(4))) Ptrs* Pp_ = (const __attribute__((address_space(4))) Ptrs*)__builtin_amdgcn_kernarg_segment_ptr(); asm volatile("" : "+s"(Pp_)); Ptrs P; P.x = Pp_->x; P.p = Pp_->p; P.w_in = Pp_->w_in; P.w_na = Pp_->w_na; P.w_gqa = Pp_->w_gqa; P.w_dil = Pp_->w_dil; P.w_diff = Pp_->w_diff; P.w_out = Pp_->w_out; P.rpb = Pp_->rpb; P.qk_gain = Pp_->qk_gain; P.lam = Pp_->lam; P.diff_gain = Pp_->diff_gain; P.t5 = Pp_->t5; P.w_router = Pp_->w_router; P.w_eg = Pp_->w_eg; P.w_eu = Pp_->w_eu; P.w_ed = Pp_->w_ed; P.w_pp = Pp_->w_pp; P.w_pg = Pp_->w_pg; P.ln_g = Pp_->ln_g; P.ln_b = Pp_->ln_b; P.out = Pp_->out; P.ws = Pp_->ws; unsigned char* ws = P.ws; (void)ws; int tid = tid0; asm volatile("" : "+v"(tid)); int bx = bx0; asm volatile("" : "+s"(bx)); \
    const int lane = tid & 63, wave = __builtin_amdgcn_readfirstlane(tid >> 6); const int vcu = (bx & 7) * (G >> 3) + (bx >> 3); const int gw = vcu * 8 + wave; (void)lane; (void)gw; (void)vcu; LAYER_PTRS
    __syncthreads();
    XcdBarrier bar = xcd_barrier_post((unsigned*)(args.P.ws + WS_CTL) + CW_BAR + args.li * XCD_BAR_WORDS, MISC + 8);
    const int lo = args.ph_lo, hi = args.ph_hi;
#ifndef PHMASK
#define PHMASK 0x3fff
#endif
#ifndef ATT_MASK
#define ATT_MASK 31
#endif
#define IN(k) (((PHMASK >> ((k) % NPH)) & 1) && lo <= (k) && (k) < hi)
#define SEAM(k) do { if (IN(k) && IN((k) + 1)) xcd_barrier(bar); } while (0)

#define ATT_GRP(g_) do { const unsigned simd_ = (unsigned)__builtin_amdgcn_s_getreg((1 << 11) | (4 << 6) | 4); \
        if (lane == 0) MISC[16 + wave] = simd_; \
        __syncthreads(); \
        int rank_ = 0; \
        _Pragma("unroll") for (int w = 0; w < 8; ++w) rank_ += (w < wave && MISC[16 + w] == simd_) ? 1 : 0; \
        g_ = __builtin_amdgcn_readfirstlane(rank_ & 1); __syncthreads(); } while (0)
    for (int L = 0; L < DEPTH; ++L) {
        const int pb = L * NPH;
        if (L == 0) { if (IN(pb + 0)) { PHASE_IDS phase_convert(P, L, lds, gw, NGW, lane, wave); }
            SEAM(pb + 0); }
        if (IN(pb + 1)) { PHASE_IDS
            pg8::SchedInProj S{XBc, (const char*)(ws + WS_WIN), G, bx};
            pg8::EpiInProj E{(bf16_t*)(ws + WS_H), (bf16_t*)(ws + WS_S)};
            pg8::gemm_phase<pg8::EpiInProj, pg8::SchedInProj>(lds, S, E, tid);
        }
        SEAM(pb + 1);
        if (IN(pb + 2)) { PHASE_IDS phase_qknorm(P, L, gw, NGW, lane);
            const bf16_t* H = (const bf16_t*)(ws + WS_H);
            LAS char* shm = (LAS char*)lds;
            int grp; ATT_GRP(grp);
            if (ATT_MASK & 8) { for (int u = vcu; u < 256; u += G) att::unit_dil_part<1>(shm, H, (bf16_t*)(ws + WS_YC), (float*)(ws + WS_AFF), P.t5, u, tid, grp);
                                for (int u = vcu; u < 256; u += G) att::unit_dil_part<2>(shm, H, (bf16_t*)(ws + WS_YC), (float*)(ws + WS_AFF), P.t5, u, tid, grp); }
        }
        SEAM(pb + 2);
        if (IN(pb + 3)) { PHASE_IDS
            const bf16_t* H = (const bf16_t*)(ws + WS_H);
            LAS char* shm = (LAS char*)lds;
            const float lam_init = (L == 0) ? 0.2f : 0.35550906759096926f;
            float* stash = (float*)(ws + WS_MERGED) + (size_t)bx * 65536;
            int grp; ATT_GRP(grp);
            if (ATT_MASK & 1) { int j = 0; for (int u = vcu; u < 512; u += G, ++j) att::unit_diff<0>(shm, H, (bf16_t*)(ws + WS_YD), P.t5, P.lam + (size_t)L * 256, P.diff_gain + (size_t)L * 128, lam_init, stash + (size_t)(j & 1) * 32768, u, tid, wave, lane, grp); }
            if (ATT_MASK & 16) { int j = 0; for (int u = vcu; u < 512; u += G, ++j) att::unit_diff<1>(shm, H, (bf16_t*)(ws + WS_YD), P.t5, P.lam + (size_t)L * 256, P.diff_gain + (size_t)L * 128, lam_init, stash + (size_t)(j & 1) * 32768, u, tid, wave, lane, grp); }
            if (ATT_MASK & 2) { int j = 0; for (int u = vcu; u < 768; u += G, ++j) { const att::SideConv side{P.w_eg + (size_t)L * NEXP * DM * FF, P.w_eu + (size_t)L * NEXP * DM * FF, P.w_ed + (size_t)L * NEXP * FF * DM, ws, vcu * 96 + j * 32};
                att::unit_gqa(shm, H, (bf16_t*)(ws + WS_YB), u, tid, wave, lane, grp, side); } }
            if (ATT_MASK & 4) for (int u = vcu; u < 768; u += G) att::unit_na(shm, H, (bf16_t*)(ws + WS_YA), P.rpb + (size_t)L * 6 * 465, u, tid, wave, lane, grp);
            if (ATT_MASK & 8) for (int u = vcu; u < 256; u += G) att::unit_dil(shm, H, (bf16_t*)(ws + WS_YC), (const float*)(ws + WS_AFF), P.t5, u, tid, wave, lane, grp);
        }
        SEAM(pb + 3);
        if (IN(pb + 4)) { PHASE_IDS
            pg8::SchedMerge S{(const char*)ws, G, bx};
            pg8::EpiGateAcc E{(const bf16_t*)(ws + WS_S), (bf16_t*)(ws + WS_MERGED)};
            pg8::gemm_phase<pg8::EpiGateAcc, pg8::SchedMerge>(lds, S, E, tid);
        }
        SEAM(pb + 4);
        if (IN(pb + 5)) { PHASE_IDS
            pg8::SchedPlain S{(const char*)(ws + WS_MERGED), (const char*)(ws + WS_WO), 2048, 16, 128, 4, G, bx, 0};
            pg8::EpiResid E{xprev, Za};
            pg8::gemm_phase<pg8::EpiResid, pg8::SchedPlain>(lds, S, E, tid);
        }
        SEAM(pb + 5);
        if (IN(pb + 6)) { PHASE_IDS phase_ln1_router(P, L, Za, lds, gw, NGW, lane, tid); }
        SEAM(pb + 6);
        if (IN(pb + 7)) { PHASE_IDS phase_topk(P, lds, bx, G, tid, lane, wave); }
        SEAM(pb + 7);
        if (IN(pb + 9)) { PHASE_IDS
            pg8::SchedFfnUp S{XBc, (const char*)(ws + WS_WGU), (const int*)(ws + WS_IDX), G, bx};
            pg8::EpiSwiGLU E{(bf16_t*)(ws + WS_HID)};
            pg8::gemm_phase<pg8::EpiSwiGLU, pg8::SchedFfnUp>(lds, S, E, tid);
        }
        SEAM(pb + 9);
        if (IN(pb + 10)) { PHASE_IDS
            pg8::SchedFfnDown S{(const char*)(ws + WS_HID), (const char*)(ws + WS_WD), G, bx};
            pg8::EpiRowScale E{(bf16_t*)(ws + WS_XIN), (const float*)(ws + WS_GATEV)};
            pg8::gemm_phase<pg8::EpiRowScale, pg8::SchedFfnDown>(lds, S, E, tid);
        }
        SEAM(pb + 10);
        if (IN(pb + 11)) { PHASE_IDS phase_ln2(P, L, gw, NGW, lane); }
        SEAM(pb + 11);
        if (IN(pb + 12)) { PHASE_IDS
            pg8::SchedPle S{XBc, (const char*)(ws + WS_WPG), (const char*)(ws + WS_PB), (const char*)(ws + WS_WPP), G, bx};
            pg8::EpiPle E{(bf16_t*)(ws + WS_MERGED), Zb, Zc};
            pg8::gemm_phase<pg8::EpiPle, pg8::SchedPle>(lds, S, E, tid);
        }
        SEAM(pb + 12);
        if (IN(pb + 13)) { PHASE_IDS phase_ln3(P, L, Zc, Xo, gw, NGW, lane); if (L + 1 < DEPTH) phase_convert(P, L + 1, lds, gw, NGW, lane, wave); }
        SEAM(pb + 13);
    }
#undef IN
#undef SEAM
}


#ifdef DBG_STOP
__global__ void dbg_dump(const unsigned char* ws, float* out, int mode) {
    const size_t i = (size_t)blockIdx.x * blockDim.x + threadIdx.x;
    if (i >= (size_t)MTOK * DM) return;
    const int m = (int)(i >> 10), c = (int)(i & 1023);
    float v = 0.f;
    auto bf = [](const unsigned char* base, size_t idx) { return __uint_as_float(((unsigned)((const bf16_t*)base)[idx]) << 16); };
    if (mode <= 2) { for (int j = 0; j < 4; ++j) v += bf(ws + WS_H, (size_t)m * HW + c + 1024 * j); if (c < 384) v += bf(ws + WS_H, (size_t)m * HW + 4096 + c); }
    else if (mode == 3) { if (c < 384) v += bf(ws + WS_YA, (size_t)m * 384 + c) + 2.f * bf(ws + WS_YB, (size_t)m * 384 + c); if (c < 256) v += 3.f * bf(ws + WS_YC, (size_t)m * 256 + c); if (c < 512) v += 4.f * bf(ws + WS_YD, (size_t)m * 512 + c); }
    else if (mode == 4) v = bf(ws + WS_MERGED, (size_t)m * DM + c);
    else if (mode == 5 || mode == 6 || mode == 12) v = ((const float*)(ws + WS_Z1))[i];
    else if (mode == 7) v = c < 16 ? (float)((const int*)(ws + WS_SLOT))[(size_t)m * 16 + c] : (c < 32 ? ((const float*)(ws + WS_AFF))[(size_t)((m >> 13) * 16 + (c - 16)) * SEQ + (m & 8191)] : 0.f);
    else if (mode == 8) v = bf(ws + WS_XIN, (size_t)m * DM + c) + bf(ws + WS_XIN, (size_t)(m + 32768) * DM + c);
    else if (mode == 9) { for (int j = 0; j < 2; ++j) v += bf(ws + WS_HID, (size_t)m * FF + c + 1024 * j) + bf(ws + WS_HID, (size_t)(m + 32768) * FF + c + 1024 * j); }
    else if (mode == 10) v = bf(ws + WS_XIN, (size_t)m * DM + c) + bf(ws + WS_XIN, (size_t)(m + 32768) * DM + c);
    else if (mode == 11) v = ((const float*)(ws + WS_Z2))[i];
    else v = ((const float*)(ws + WS_Z1))[i];
    out[i] = v;
}
#endif
extern "C" void kernel_launch(void* const* d_in, const int* in_sizes, int n_in, void* d_out, int out_size, void* d_ws, size_t ws_size, hipStream_t stream) {
    static int grid = 0;
    if (grid == 0) {
        if (n_in != 21 || out_size != MTOK * DM || ws_size < WS_END) { fprintf(stderr, "kernel_launch: unexpected shapes (n_in %d out %d ws %zu need %zu)\n", n_in, out_size, ws_size, (size_t)WS_END); grid = -1; return; }
        int dev = 0, cus = 0;
        if (hipGetDevice(&dev) != hipSuccess || hipDeviceGetAttribute(&cus, hipDeviceAttributeMultiprocessorCount, dev) != hipSuccess) { grid = -1; return; }
        if (hipFuncSetAttribute((const void*)mega_fwd, hipFuncAttributeMaxDynamicSharedMemorySize, LDS_BYTES) != hipSuccess) { fprintf(stderr, "kernel_launch: hipFuncSetAttribute failed\n"); grid = -1; return; }
        int per_cu = 0;
        if (hipOccupancyMaxActiveBlocksPerMultiprocessor(&per_cu, (const void*)mega_fwd, 512, LDS_BYTES) != hipSuccess || per_cu < 1) fprintf(stderr, "kernel_launch: occupancy query reports %d\n", per_cu);
        (void)hipGetLastError();
        grid = 256;
        if (cus != 256) fprintf(stderr, "kernel_launch: %d CUs reported; this kernel is built for 256\n", cus);
    }
    if (grid < 0) return;
    (void)hipMemsetAsync((char*)d_ws + WS_CTL, 0, CTL_ZERO_BYTES, stream);
    Args a{};
    const float* const* in = (const float* const*)d_in;
    a.P.x = in[0]; a.P.p = in[1]; a.P.w_in = in[2]; a.P.w_na = in[3]; a.P.w_gqa = in[4]; a.P.w_dil = in[5]; a.P.w_diff = in[6]; a.P.w_out = in[7];
    a.P.rpb = in[8]; a.P.qk_gain = in[9]; a.P.lam = in[10]; a.P.diff_gain = in[11]; a.P.t5 = in[12]; a.P.w_router = in[13];
    a.P.w_eg = in[14]; a.P.w_eu = in[15]; a.P.w_ed = in[16]; a.P.w_pp = in[17]; a.P.w_pg = in[18]; a.P.ln_g = in[19]; a.P.ln_b = in[20];
    a.P.out = (float*)d_out; a.P.ws = (unsigned char*)d_ws;
#ifdef DBG_STOP
    for (int li = 0; li <= DBG_STOP; ++li) { a.ph_lo = li; a.ph_hi = li + 1; hipLaunchKernelGGL(mega_fwd, dim3(grid), dim3(512), LDS_BYTES, stream, a); }
    hipLaunchKernelGGL(dbg_dump, dim3(MTOK * DM / 256), dim3(256), 0, stream, (const unsigned char*)d_ws, (float*)d_out, (int)DBG_STOP);
#else
#ifdef DUP_MASK
    { int li = 0;
      for (int ph = 0; ph < DEPTH * NPH; ++ph) { const int reps = ((DUP_MASK >> (ph % NPH)) & 1) ? 2 : 1;
          for (int r = 0; r < reps; ++r) { a.li = (li++) % 8; a.ph_lo = ph; a.ph_hi = ph + 1; hipLaunchKernelGGL(mega_fwd, dim3(grid), dim3(512), LDS_BYTES, stream, a); } } }
#else
#ifndef N_SPLIT
#define N_SPLIT 1
#endif
    for (int li = 0; li < N_SPLIT; ++li) {
        a.li = li % 8; a.ph_lo = li * (DEPTH * NPH) / N_SPLIT; a.ph_hi = (li + 1) * (DEPTH * NPH) / N_SPLIT;
        hipLaunchKernelGGL(mega_fwd, dim3(grid), dim3(512), LDS_BYTES, stream, a);
    }
#endif
#endif
}
```

```cpp
#include <hip/hip_runtime.h>
#include <cstdio>
#include <cstdint>

#define LAS __attribute__((address_space(3)))
#define GAS __attribute__((address_space(1)))
typedef unsigned short bf16_t;
typedef short bf16x8 __attribute__((ext_vector_type(8)));
typedef short s16x4 __attribute__((ext_vector_type(4)));
typedef float f32x2 __attribute__((ext_vector_type(2)));
typedef float f32x4 __attribute__((ext_vector_type(4)));
typedef float f32x16 __attribute__((ext_vector_type(16)));
typedef unsigned u32x2 __attribute__((ext_vector_type(2)));
typedef unsigned u32x4 __attribute__((ext_vector_type(4)));

constexpr int DM = 1024, NB = 4, SEQ = 8192, MTOK = NB * SEQ, DEPTH = 2;
constexpr int INW = 8576, HW = 4608, NGATE = 4096;
constexpr int C_QA = 0, C_KA = 384, C_VA = 768, C_QB = 1152, C_KB = 1536, C_VB = 1664, C_QC = 1792, C_KC = 2176, C_VC = 2560, C_QD = 2944, C_KD = 3456, C_VD = 3968, C_HEND = 4480;
constexpr int NEXP = 16, CAP = 1024, FF = 2048, PLE = 256;
constexpr float LOG2E = 1.4426950408889634f;
constexpr float QSCALE = 0.125f * LOG2E;
constexpr float ALPHA = 1.4142135623730951f;
constexpr float LN_EPS = 1e-5f;

constexpr size_t MiB = 1u << 20;
constexpr size_t WS_CTL = 0, CTL_ZERO_BYTES = 256 * 1024;
constexpr size_t WS_WIN = 1 * MiB;
constexpr size_t WS_WG = 10 * MiB;
constexpr size_t WS_WNA = 18 * MiB;
constexpr size_t WS_WGQA = WS_WNA + 768 * 1024;
constexpr size_t WS_WDIL = WS_WGQA + 768 * 1024;
constexpr size_t WS_WDIFF = 20 * MiB;
constexpr size_t WS_WO = 21 * MiB;
constexpr size_t WS_WPG = 23 * MiB;
constexpr size_t WS_WPP = 25 * MiB;
constexpr size_t WS_WGU = 27 * MiB;
constexpr size_t WS_WD = 155 * MiB;
constexpr size_t WS_Z1 = 219 * MiB;
constexpr size_t WS_Z2 = 347 * MiB;
constexpr size_t WS_S = WS_Z1;
static_assert(WS_WIN + (size_t)HW * DM * 2 == WS_WG && WS_Z1 + 128 * MiB == WS_Z2, "contiguity");
constexpr size_t WS_XB = 475 * MiB;
constexpr size_t WS_PB = 539 * MiB;
constexpr size_t WS_AFF = 555 * MiB;
constexpr size_t WS_SLOT = 557 * MiB;
constexpr size_t WS_IDX = 559 * MiB;
constexpr size_t WS_GATEV = WS_IDX + 256 * 1024;
constexpr size_t WS_R = 560 * MiB;
constexpr size_t WS_H = WS_R;
constexpr size_t WS_YA = WS_R + 288 * MiB;
constexpr size_t WS_YB = WS_YA + 24 * MiB;
constexpr size_t WS_YC = WS_YB + 24 * MiB;
constexpr size_t WS_YD = WS_YC + 16 * MiB;
constexpr size_t WS_MERGED = WS_YD + 32 * MiB;
constexpr size_t WS_END = WS_MERGED + 64 * MiB;
constexpr size_t WS_XIN = WS_R;
constexpr size_t WS_HID = WS_R + 128 * MiB;
static_assert(WS_HID + 256 * MiB <= WS_MERGED, "ffn overlay");
constexpr int CW_BAR = 1024;

constexpr int LDS_BYTES = 147456;
constexpr int MISC_OFF = 131072 + 320;

typedef __bf16 bf16x2_t __attribute__((ext_vector_type(2)));
__device__ __forceinline__ unsigned cvt_pk_bf16(float lo, float hi) { f32x2 v = {lo, hi}; bf16x2_t b = __builtin_convertvector(v, bf16x2_t); return __builtin_bit_cast(unsigned, b); }
__device__ __forceinline__ float bf_lo(unsigned w) { return __uint_as_float(w << 16); }
__device__ __forceinline__ float bf_hi(unsigned w) { return __uint_as_float(w & 0xffff0000u); }
__device__ __forceinline__ float fast_sigmoid(float x) { return __builtin_amdgcn_rcpf(1.0f + __builtin_amdgcn_exp2f(-x * LOG2E)); }
__device__ __forceinline__ float wave_sum(float v) {
#pragma unroll
    for (int o = 1; o < 64; o <<= 1) v += __shfl_xor(v, o);
    return v;
}
#define LDS_WAIT() asm volatile("s_waitcnt lgkmcnt(0)" ::: "memory")
#define VM_WAIT() asm volatile("s_waitcnt vmcnt(0)" ::: "memory")

#define XB_TMO      128
#define XB_XCNT(j)  (256  + 64 * (j))
#define XB_XSUB(j)  (1280 + 64 * (j))
#define XB_XGEN(j)  (2304 + 64 * (j))
#define XB_TOP      3328
#define XB_TOPGEN   3392
#define XCD_BAR_WORDS 3456
#define XB_SPIN_CAP (1u << 22)
__device__ __forceinline__ unsigned xb_ld(unsigned* p)              { return __hip_atomic_load(p, __ATOMIC_RELAXED, __HIP_MEMORY_SCOPE_AGENT); }
__device__ __forceinline__ unsigned xb_add(unsigned* p, unsigned v) { return __hip_atomic_fetch_add(p, v, __ATOMIC_RELAXED, __HIP_MEMORY_SCOPE_AGENT); }
__device__ __forceinline__ unsigned xb_xcc_id() { return (unsigned)__builtin_amdgcn_s_getreg((3 << 11) | 20) & 0xFu; }
#define XB_SPIN(cond, bar) do { unsigned _sp = 0; while (cond) { __builtin_amdgcn_s_sleep(1); \
    if ((++_sp & 255u) == 0u) { if (xb_ld(&(bar)[XB_TMO])) break; if (_sp > XB_SPIN_CAP) { atomicAdd(&(bar)[XB_TMO], 1u); break; } } } } while (0)
struct XcdBarrier { unsigned* bar; unsigned x; volatile LAS unsigned* st; };
__device__ __forceinline__ XcdBarrier xcd_barrier_post(unsigned* bar, volatile LAS unsigned* st) {
    XcdBarrier b; b.bar = bar; b.x = xb_xcc_id(); b.st = st;
    if (threadIdx.x == 0) (void)xb_add(&bar[XB_XCNT(b.x)], 1u);
    return b;
}
__device__ __forceinline__ void xcd_barrier_complete(unsigned* bar, unsigned x, unsigned& nloc, unsigned& nx) {
    const unsigned G = gridDim.x * gridDim.y * gridDim.z;
    unsigned sum, cnt, mine, sp = 0u;
    for (;;) {
        sum = 0u; cnt = 0u; mine = 0u;
#pragma unroll
        for (unsigned j = 0; j < 16; ++j) { const unsigned c = xb_ld(&bar[XB_XCNT(j)]); sum += c; cnt += (c > 0u) ? 1u : 0u; mine = (j == x) ? c : mine; }
        if (sum == G) break;
        __builtin_amdgcn_s_sleep(1);
        if ((++sp & 255u) == 0u) { if (xb_ld(&bar[XB_TMO])) break; if (sp > XB_SPIN_CAP) { atomicAdd(&bar[XB_TMO], 1u); break; } }
    }
    nloc = mine > 0u ? mine : 1u; nx = cnt > 0u ? cnt : 1u;
}
__device__ __forceinline__ void xcd_barrier(const XcdBarrier& b) {
    asm volatile("s_waitcnt vmcnt(0)" ::: "memory");
    __syncthreads();
    if (threadIdx.x == 0) {
        unsigned* bar = b.bar;
        __builtin_amdgcn_s_waitcnt(0);
        unsigned nloc = b.st[0], nx = b.st[1];
        if (nloc == 0u) { xcd_barrier_complete(bar, b.x, nloc, nx); b.st[0] = nloc; b.st[1] = nx; }
        const unsigned old = xb_add(&bar[XB_XSUB(b.x)], 1u);
        const unsigned gen = old / nloc;
        if (old + 1u == (gen + 1u) * nloc) {
            __builtin_amdgcn_fence(__ATOMIC_RELEASE, "agent");
            asm volatile("s_waitcnt vmcnt(0)" ::: "memory");
            const unsigned og = xb_add(&bar[XB_TOP], 1u);
            const unsigned tg = og / nx;
            if (og + 1u == (tg + 1u) * nx) xb_add(&bar[XB_TOPGEN], 1u);
            else XB_SPIN(xb_ld(&bar[XB_TOPGEN]) == tg, bar);
            __builtin_amdgcn_fence(__ATOMIC_ACQUIRE, "agent");
            xb_add(&bar[XB_XGEN(b.x)], 1u);
            asm volatile("s_waitcnt vmcnt(0)" ::: "memory");
        } else {
            XB_SPIN(xb_ld(&bar[XB_XGEN(b.x)]) == gen, bar);
            __builtin_amdgcn_fence(__ATOMIC_ACQUIRE, "agent");
            asm volatile("s_waitcnt vmcnt(0)" ::: "memory");
        }
    }
    __syncthreads();
}

namespace pg8 {
constexpr int BM = 256, BK = 64, HALF = 128, HTB = HALF * BK * 2, STAGE_BYTES = 8 * HTB, NXCD = 8, WGM = 8;
__host__ __device__ __forceinline__ int lds_byte(int r, int c) { const int st = (r >> 4) * 2 + (c >> 5), rr = r & 15, cc = c & 31, ob = rr * 64 + cc * 2; return st * 1024 + (ob ^ (((ob >> 9) & 1) << 5)); }
__host__ __device__ __forceinline__ void stage_rc(int b, int& R, int& C) { const int st = b / 1024, sb = b % 1024, swz = sb ^ (((sb >> 9) & 1) << 5); R = (st >> 1) * 16 + swz / 64; C = (st & 1) * 32 + (swz % 64) / 2; }
__host__ __device__ __forceinline__ int perm32(int rho) { const int n = rho >> 4, i = rho & 15; return 8 * (i >> 2) + 4 * n + (i & 3); }

struct Unit { const char* A; const char* B; int K2; int nt; int pm, pn, tag; };

__device__ __forceinline__ void tile_map(int L, int nM, int nN, int& pm, int& pn) {
    const int nwg = nM * nN; int wgid = L;
    { const int q = nwg / NXCD, r = nwg % NXCD, xcd = wgid % NXCD, off = wgid / NXCD; wgid = (xcd < r ? xcd * (q + 1) : r * (q + 1) + (xcd - r) * q) + off; }
    const int nig = WGM * nN, gid = wgid / nig, fm = gid * WGM, gsz = (nM - fm) < WGM ? (nM - fm) : WGM;
    pm = fm + ((wgid % nig) % gsz); pn = (wgid % nig) / gsz;
}

template <class Epi, class Sched>
__device__ __forceinline__ void gemm_phase(LAS unsigned char* lds, const Sched& S, const Epi& E, const int tid) {
    const int wid = __builtin_amdgcn_readfirstlane(tid >> 6), lane = tid & 63, wr = wid >> 2, wc = wid & 3, fr = lane & 15, fq = lane >> 4;
    int R0, C0; stage_rc(tid * 16, R0, C0);
    const int Rb0 = (R0 & ~31) + perm32(R0 & 31);
    const int Rbp = 2 * (R0 & ~31) + perm32(R0 & 31);
    const unsigned C02 = (unsigned)C0 * 2u;
    const size_t kstep = (size_t)(BK * 2);
    const unsigned ldsw = (unsigned)wid * 1024u;
    const int aoff = lds_byte(wr * 64 + fr, fq * 8), boff = lds_byte(wc * 32 + fr, fq * 8);
#define PG8_SA(b, h) (((b) * 2 + (h)) * HTB)
#define PG8_SB(b, h) ((4 + (b) * 2 + (h)) * HTB)
#define PG8_STAGE(bufoff, gbase, K2_, R_) do { _Pragma("unroll") for (int _i = 0; _i < 2; ++_i) \
        __builtin_amdgcn_global_load_lds((const unsigned*)((const char*)(gbase) + (unsigned)(((R_) + 64 * _i) * (K2_)) + C02), (LAS unsigned*)(lds + (bufoff) + ldsw + _i * 8192), 16, 0, 0); } while (0)
#define PG8_STAGE_B(bufoff, gb, h_, hs_, K2_) do { if constexpr (BP) { _Pragma("unroll") for (int _i = 0; _i < 2; ++_i) \
        __builtin_amdgcn_global_load_lds((const unsigned*)((const char*)(gb) + (size_t)(32 * (h_)) * (K2_) + (unsigned)((Rbp + 128 * _i) * (K2_)) + C02), (LAS unsigned*)(lds + (bufoff) + ldsw + _i * 8192), 16, 0, 0); } \
        else PG8_STAGE(bufoff, (const char*)(gb) + (h_) * (hs_), K2_, Rb0); } while (0)
#define PG8_STAGE_A(bufoff, gk, h_, hs_, K2_, AR_) do { if constexpr (GA) { _Pragma("unroll") for (int _i = 0; _i < 2; ++_i) \
        __builtin_amdgcn_global_load_lds((const unsigned*)((const char*)(gk) + AR_[h_][_i] + C02), (LAS unsigned*)(lds + (bufoff) + ldsw + _i * 8192), 16, 0, 0); } \
        else if constexpr (AB) { _Pragma("unroll") for (int _i = 0; _i < 2; ++_i)     \
        __builtin_amdgcn_global_load_lds((const unsigned*)((const char*)(gk) + (size_t)(h_) * 524288 + (unsigned)((((wid >> 1) + 4 * _i) * 64 + (wid & 1)) * 1024 + lane * 16)), (LAS unsigned*)(lds + (bufoff) + ldsw + _i * 8192), 16, 0, 0); } \
        else PG8_STAGE(bufoff, (const char*)(gk) + (h_) * (hs_), K2_, R0); } while (0)
#define PG8_LDA(dst, b, h) do { _Pragma("unroll") for (int m = 0; m < 4; ++m) _Pragma("unroll") for (int k = 0; k < 2; ++k) dst[m][k] = *(const LAS bf16x8*)(lds + PG8_SA(b, h) + aoff + m * 2048 + k * 1024); } while (0)
#define PG8_LDB(dst, b, h) do { _Pragma("unroll") for (int n = 0; n < 2; ++n) _Pragma("unroll") for (int k = 0; k < 2; ++k) dst[n][k] = *(const LAS bf16x8*)(lds + PG8_SB(b, h) + boff + n * 2048 + k * 1024); } while (0)
#define PG8_MMA(ai, bj, At, Bt) do { __builtin_amdgcn_s_setprio(1); _Pragma("unroll") for (int m = 0; m < 4; ++m) _Pragma("unroll") for (int n = 0; n < 2; ++n) _Pragma("unroll") for (int k = 0; k < 2; ++k) \
        acc[ai][bj][m][n] = __builtin_amdgcn_mfma_f32_16x16x32_bf16(Bt[n][k], At[m][k], acc[ai][bj][m][n], 0, 0, 0); __builtin_amdgcn_s_setprio(0); } while (0)
#define PG8_WAIT_V(n) asm volatile("s_waitcnt vmcnt(" #n ")" ::: "memory")
#define PG8_WAIT_L(n) asm volatile("s_waitcnt lgkmcnt(" #n ")" ::: "memory")
#define PG8_BAR __builtin_amdgcn_s_barrier()
#define PG8_SCHED __builtin_amdgcn_sched_barrier(0)
    constexpr bool GA = Sched::GATHER;
    constexpr bool BP = Sched::BPERM;
    constexpr bool AB = Sched::ABLK;
    const size_t kstepA = AB ? (size_t)2048 : (size_t)(BK * 2);
    constexpr int IDXL = 133120;
    Unit cur, nxt; int ui = 0;
    if (!S.next(0, cur)) return;
    unsigned arc[2][2] = {{0u, 0u}, {0u, 0u}}, arn[2][2] = {{0u, 0u}, {0u, 0u}};
    if constexpr (GA) {
#pragma unroll
        for (int h = 0; h < 2; ++h)
#pragma unroll
            for (int i = 0; i < 2; ++i) arc[h][i] = (unsigned)S.rows(cur)[R0 + 64 * i + 128 * h] * (unsigned)cur.K2;
    }
    f32x4 acc[2][2][4][2];
#pragma unroll
    for (int a = 0; a < 2; ++a)
#pragma unroll
        for (int b = 0; b < 2; ++b)
#pragma unroll
            for (int m = 0; m < 4; ++m)
#pragma unroll
                for (int n = 0; n < 2; ++n) acc[a][b][m][n] = (f32x4){0.f, 0.f, 0.f, 0.f};
    bf16x8 At[4][2], B0[2][2], B1[2][2];
    const char* cA = cur.A; const char* cB = cur.B; int K2c = cur.K2; size_t hsc = (size_t)HALF * K2c;
    PG8_STAGE_B(PG8_SB(0, 0), cB, 0, hsc, K2c); PG8_STAGE_B(PG8_SB(0, 1), cB, 1, hsc, K2c); PG8_STAGE_A(PG8_SA(0, 0), cA, 0, hsc, K2c, arc); PG8_STAGE_A(PG8_SA(0, 1), cA, 1, hsc, K2c, arc);
    if (wr == 1) PG8_BAR;
    PG8_WAIT_V(2); PG8_BAR;
    PG8_STAGE_B(PG8_SB(1, 0), cB + kstep, 0, hsc, K2c); PG8_STAGE_A(PG8_SA(1, 0), cA + kstepA, 0, hsc, K2c, arc); PG8_STAGE_B(PG8_SB(1, 1), cB + kstep, 1, hsc, K2c);
    PG8_WAIT_V(6); PG8_BAR;
    for (;;) {
        const bool has_next = S.next(ui + 1, nxt);
        const char* nA = has_next ? nxt.A : cA; const char* nB = has_next ? nxt.B : cB; const int K2n = has_next ? nxt.K2 : K2c;
        const int nt = cur.nt;
        if constexpr (GA) {
            if (wid < 4) __builtin_amdgcn_global_load_lds((const unsigned*)(S.rows(has_next ? nxt : cur) + wid * 64 + lane), (LAS unsigned*)(lds + IDXL + wid * 256), 4, 0, 0);
        }
        for (int t = 0; t < nt; t += 2) {
            const bool last = (t == nt - 2);
            unsigned arx[2][2] = {{0u, 0u}, {0u, 0u}};
            if constexpr (GA) {
                if (last) {
#pragma unroll
                    for (int h = 0; h < 2; ++h)
#pragma unroll
                        for (int i = 0; i < 2; ++i) arn[h][i] = *(const LAS unsigned*)(lds + IDXL + 4 * (R0 + 64 * i + 128 * h)) * (unsigned)K2n;
                }
#pragma unroll
                for (int h = 0; h < 2; ++h)
#pragma unroll
                    for (int i = 0; i < 2; ++i) arx[h][i] = last ? arn[h][i] : arc[h][i];
            }
            const char* a1 = cA + (size_t)(t + 1) * kstepA;
            const char* a2 = last ? nA : cA + (size_t)(t + 2) * kstepA; const char* b2 = last ? nB : cB + (size_t)(t + 2) * kstep;
            const int K2x = last ? K2n : K2c; const size_t hsx = (size_t)HALF * K2x;
            const char* a3 = a2 + kstepA; const char* b3 = b2 + kstep;
            PG8_LDB(B0, 0, 0); PG8_LDB(B1, 0, 1); PG8_SCHED; PG8_LDA(At, 0, 0); PG8_STAGE_A(PG8_SA(1, 1), a1, 1, hsc, K2c, arc);
            PG8_WAIT_V(8); PG8_WAIT_L(0); PG8_BAR; PG8_MMA(0, 0, At, B0); PG8_MMA(0, 1, At, B1); PG8_BAR; PG8_SCHED;
            PG8_LDA(At, 0, 1); PG8_STAGE_B(PG8_SB(0, 0), b2, 0, hsx, K2x); PG8_STAGE_B(PG8_SB(0, 1), b2, 1, hsx, K2x); PG8_STAGE_A(PG8_SA(0, 0), a2, 0, hsx, K2x, arx);
            PG8_WAIT_V(8); PG8_WAIT_L(0); PG8_BAR; PG8_MMA(1, 0, At, B0); PG8_MMA(1, 1, At, B1); PG8_BAR; PG8_SCHED;
            PG8_LDB(B0, 1, 0); PG8_LDB(B1, 1, 1); PG8_SCHED; PG8_LDA(At, 1, 0); PG8_STAGE_A(PG8_SA(0, 1), a2, 1, hsx, K2x, arx);
            PG8_WAIT_V(8); PG8_WAIT_L(0); PG8_BAR; PG8_MMA(0, 0, At, B0); PG8_MMA(0, 1, At, B1); PG8_BAR; PG8_SCHED;
            PG8_LDA(At, 1, 1); PG8_STAGE_B(PG8_SB(1, 0), b3, 0, hsx, K2x); PG8_STAGE_B(PG8_SB(1, 1), b3, 1, hsx, K2x); PG8_STAGE_A(PG8_SA(1, 0), a3, 0, hsx, K2x, arx);
            PG8_WAIT_V(8); PG8_WAIT_L(0); PG8_BAR; PG8_MMA(1, 0, At, B0); PG8_MMA(1, 1, At, B1); PG8_BAR; PG8_SCHED;
        }
        if (wr == 0) PG8_BAR;
        const bool keep = E(acc, cur, wr, wc, fr, fq);
        if (!has_next) break;
        if (!keep) {
#pragma unroll
        for (int a = 0; a < 2; ++a)
#pragma unroll
            for (int b = 0; b < 2; ++b)
#pragma unroll
                for (int m = 0; m < 4; ++m)
#pragma unroll
                    for (int n = 0; n < 2; ++n) acc[a][b][m][n] = (f32x4){0.f, 0.f, 0.f, 0.f};
        }
        cur = nxt; cA = nA; cB = nB; K2c = K2n; hsc = (size_t)HALF * K2c; ++ui;
        if constexpr (GA) {
#pragma unroll
            for (int h = 0; h < 2; ++h)
#pragma unroll
                for (int i = 0; i < 2; ++i) arc[h][i] = arn[h][i];
        }
        if (wr == 1) PG8_BAR;
    }
    PG8_WAIT_V(0);
    PG8_BAR;
#undef PG8_SA
#undef PG8_SB
#undef PG8_STAGE
#undef PG8_STAGE_A
#undef PG8_STAGE_B
#undef PG8_LDA
#undef PG8_LDB
#undef PG8_MMA
#undef PG8_WAIT_V
#undef PG8_WAIT_L
#undef PG8_BAR
#undef PG8_SCHED
}

struct SchedPlain { static constexpr bool ABLK = false; static constexpr bool BPERM = true;          static constexpr bool GATHER = false; __device__ __forceinline__ const int* rows(const Unit&) const { return nullptr; }
    const char* A; const char* B; int K2, nt, nM, nN, G, c, bmode;
    __device__ __forceinline__ bool next(int i, Unit& u) const {
        const long L = (long)i * G + c; if (L >= (long)nM * nN) return false;
        tile_map((int)L, nM, nN, u.pm, u.pn);
        const int bt = bmode == 0 ? u.pn : (bmode == 1 ? (u.pm >> 4) * 16 + u.pn : (u.pm >> 4) * 4 + u.pn);
        u.A = A + (size_t)u.pm * 256 * K2; u.B = B + (size_t)bt * 256 * K2; u.K2 = K2; u.nt = nt; u.tag = 0; return true;
    }
};
struct SchedInProj {
    static constexpr bool GATHER = false, BPERM = true, ABLK = false; __device__ __forceinline__ const int* rows(const Unit&) const { return nullptr; }
    const char* A; const char* B; int G, c;
    __device__ __forceinline__ bool next(int i, Unit& u) const {
        const long L = (long)i * G + c; if (L >= 128L * 34) return false;
        tile_map((int)L, 128, 34, u.pm, u.pn);
        u.A = A + (size_t)u.pm * 256 * 2048; u.B = B + (size_t)u.pn * 256 * 2048; u.K2 = 2048; u.nt = 16; u.tag = 0; return true;
    }
};
struct SchedFfnDown {
    static constexpr bool GATHER = false, BPERM = true, ABLK = true;
    __device__ __forceinline__ const int* rows(const Unit&) const { return nullptr; }
    const char* A; const char* B; int G, c;
    __device__ __forceinline__ bool next(int i, Unit& u) const {
        const long L = (long)i * G + c; if (L >= 256L * 4) return false;
        tile_map((int)L, 256, 4, u.pm, u.pn);
        u.A = A + (size_t)u.pm * 256 * 4096; u.B = B + (size_t)((u.pm >> 4) * 4 + u.pn) * 256 * 4096; u.K2 = 4096; u.nt = 32; u.tag = 0; return true;
    }
};
struct SchedFfnUp { static constexpr bool ABLK = false; static constexpr bool BPERM = false;
    static constexpr bool GATHER = true;
    const char* X; const char* B; const int* idx; int G, c;
    __device__ __forceinline__ const int* rows(const Unit& u) const { return idx + u.pm * 256; }
    __device__ __forceinline__ bool next(int i, Unit& u) const {
        const long L = (long)i * G + c; if (L >= 256L * 16) return false;
        tile_map((int)L, 256, 16, u.pm, u.pn);
        u.A = X; u.B = B + (size_t)((u.pm >> 4) * 16 + u.pn) * 256 * 2048; u.K2 = 2048; u.nt = 16; u.tag = 0; return true;
    }
};
struct SchedMerge { static constexpr bool ABLK = false; static constexpr bool BPERM = true;     static constexpr bool GATHER = false; __device__ __forceinline__ const int* rows(const Unit&) const { return nullptr; }
    const char* ws; int G, c;
    __device__ __forceinline__ bool next(int i, Unit& u) const {
        const long L = (long)(i >> 2) * G + c; if (L >= 128 * 4) return false;
        tile_map((int)L, 128, 4, u.pm, u.pn);
        const int b = i & 3; u.tag = b;
        const int ge1 = b >= 1 ? 1 : 0, ge2 = b >= 2 ? 1 : 0, ge3 = b >= 3 ? 1 : 0;
        const int K2 = 768 - ge2 * 256 + ge3 * 512;
        const size_t yoff = WS_YA + (size_t)ge1 * (WS_YB - WS_YA) + (size_t)ge2 * (WS_YC - WS_YB) + (size_t)ge3 * (WS_YD - WS_YC);
        const size_t woff = WS_WNA + (size_t)ge1 * (WS_WGQA - WS_WNA) + (size_t)ge2 * (WS_WDIL - WS_WGQA) + (size_t)ge3 * (WS_WDIFF - WS_WDIL);
        u.K2 = K2; u.nt = K2 >> 7; u.A = ws + yoff + (size_t)u.pm * 256 * K2; u.B = ws + woff + (size_t)u.pn * 256 * K2;
        return true;
    }
};
struct SchedPle { static constexpr bool ABLK = false; static constexpr bool BPERM = true;       static constexpr bool GATHER = false; __device__ __forceinline__ const int* rows(const Unit&) const { return nullptr; }
    const char* XB; const char* WPG; const char* PB; const char* WPP; int G, c;
    __device__ __forceinline__ bool next(int i, Unit& u) const {
        const long L = (long)(i >> 1) * G + c; if (L >= 128 * 4) return false;
        tile_map((int)L, 128, 4, u.pm, u.pn);
        u.tag = i & 1;
        if (u.tag == 0) { u.K2 = 2048; u.nt = 16; u.A = XB + (size_t)u.pm * 256 * 2048; u.B = WPG + (size_t)u.pn * 256 * 2048; }
        else { u.K2 = 512; u.nt = 4; u.A = PB + (size_t)u.pm * 256 * 512; u.B = WPP + (size_t)u.pn * 256 * 512; }
        return true;
    }
};

#define EPI_ROWS_BEGIN  _Pragma("unroll") for (int ai = 0; ai < 2; ++ai) _Pragma("unroll") for (int m = 0; m < 4; ++m) { const int row = u.pm * 256 + ai * 128 + wr * 64 + m * 16 + fr;
#define EPI_ROWS_END    }
__device__ __forceinline__ u32x4 pack8(const f32x4 v0, const f32x4 v1) { u32x4 w; w.x = cvt_pk_bf16(v0[0], v0[1]); w.y = cvt_pk_bf16(v0[2], v0[3]); w.z = cvt_pk_bf16(v1[0], v1[1]); w.w = cvt_pk_bf16(v1[2], v1[3]); return w; }

__device__ __forceinline__ u32x4 ld16_sc1(const void* p) {
    const unsigned long long a = __hip_atomic_load((const unsigned long long*)p, __ATOMIC_RELAXED, __HIP_MEMORY_SCOPE_AGENT);
    const unsigned long long b = __hip_atomic_load((const unsigned long long*)p + 1, __ATOMIC_RELAXED, __HIP_MEMORY_SCOPE_AGENT);
    u32x4 r; r.x = (unsigned)a; r.y = (unsigned)(a >> 32); r.z = (unsigned)b; r.w = (unsigned)(b >> 32); return r; }
__device__ __forceinline__ f32x4 ld16f_sc1(const void* p) { return __builtin_bit_cast(f32x4, ld16_sc1(p)); }
struct EpiInProj {
    bf16_t* H; bf16_t* S;
    static __device__ __forceinline__ u32x4 swap1(const u32x4 v) { u32x4 r; r.x = (unsigned)__builtin_amdgcn_update_dpp(0, (int)v.x, 0xB1, 0xF, 0xF, false); r.y = (unsigned)__builtin_amdgcn_update_dpp(0, (int)v.y, 0xB1, 0xF, 0xF, false);
        r.z = (unsigned)__builtin_amdgcn_update_dpp(0, (int)v.z, 0xB1, 0xF, 0xF, false); r.w = (unsigned)__builtin_amdgcn_update_dpp(0, (int)v.w, 0xB1, 0xF, 0xF, false); return r; }
    __device__ __forceinline__ bool operator()(f32x4 (&acc)[2][2][4][2], const Unit& u, int wr, int wc, int fr_, int fq) const {
        int fr = fr_; asm volatile("" : "+v"(fr));
        const bool odd = (fr & 1) != 0;
        const int cw = wc * 64 + 8 * fq + (odd ? 32 : 0);
        const int re = wr * 64 + (fr & ~1);
#define INPROJ_STORE(rp_, ld_, w0_, w1_) do { const u32x4 send_ = odd ? (w0_) : (w1_), recv_ = swap1(send_); \
            __builtin_nontemporal_store(odd ? recv_ : (w0_), (u32x4*)(rp_)); __builtin_nontemporal_store(odd ? (w1_) : recv_, (u32x4*)((rp_) + (ld_))); } while (0)
        if (u.pn < 18) {
            bf16_t* base = H + (size_t)(u.pm * 256 + re) * HW + u.pn * 256 + cw;
#pragma unroll
            for (int ai = 0; ai < 2; ++ai)
#pragma unroll
                for (int m = 0; m < 4; ++m) { const u32x4 w0 = pack8(acc[ai][0][m][0], acc[ai][0][m][1]), w1 = pack8(acc[ai][1][m][0], acc[ai][1][m][1]);
                    INPROJ_STORE(base + (size_t)(ai * 128 + m * 16) * HW, HW, w0, w1); }
        } else {
            bf16_t* base = S + (size_t)(u.pm * 256 + re) * NGATE + (u.pn - 18) * 256 + cw;
#pragma unroll
            for (int ai = 0; ai < 2; ++ai)
#pragma unroll
                for (int m = 0; m < 4; ++m) {
                    f32x4 a0 = acc[ai][0][m][0], a1 = acc[ai][0][m][1], b0 = acc[ai][1][m][0], b1 = acc[ai][1][m][1];
#pragma unroll
                    for (int j = 0; j < 4; ++j) { a0[j] = fmaxf(fast_sigmoid(a0[j]), 1e-18f); a1[j] = fmaxf(fast_sigmoid(a1[j]), 1e-18f); b0[j] = fmaxf(fast_sigmoid(b0[j]), 1e-18f); b1[j] = fmaxf(fast_sigmoid(b1[j]), 1e-18f); }
                    const u32x4 w0 = pack8(a0, a1), w1 = pack8(b0, b1);
                    INPROJ_STORE(base + (size_t)(ai * 128 + m * 16) * NGATE, NGATE, w0, w1); }
        }
#undef INPROJ_STORE
        return false;
    }
};
struct EpiGateAcc {
    const bf16_t* S; bf16_t* MG;
    __device__ __forceinline__ bool operator()(f32x4 (&acc)[2][2][4][2], const Unit& u, int wr, int wc, int fr_, int fq) const {
        int fr = fr_; asm volatile("" : "+v"(fr));
        const bool odd = (fr & 1) != 0; const int b = u.tag;
        const int cw = u.pn * 256 + wc * 64 + 8 * fq + (odd ? 32 : 0);
        const size_t rowe = (size_t)(u.pm * 256 + wr * 64 + (fr & ~1));
        const bf16_t* sc = S + rowe * NGATE + b * 1024 + cw;
#pragma unroll
        for (int ai = 0; ai < 2; ++ai) {
                u32x4 l0[4][2], l1[4][2];
#pragma unroll
                for (int mm = 0; mm < 4; ++mm)
#pragma unroll
                    for (int par = 0; par < 2; ++par) {
                        const size_t ro = (size_t)(ai * 128 + mm * 16 + par) * NGATE;
                        l0[mm][par] = *(const u32x4*)(sc + ro);
                        if (b < 3) l1[mm][par] = *(const u32x4*)(sc + ro + 1024); else l1[mm][par] = (u32x4){0x3f803f80u, 0x3f803f80u, 0x3f803f80u, 0x3f803f80u};
                    }
                asm volatile("" ::: "memory");
#pragma unroll
                for (int mm = 0; mm < 4; ++mm) {
                    const int m = mm;
                    const u32x4 ar = EpiInProj::swap1(odd ? l0[mm][0] : l0[mm][1]), dr = EpiInProj::swap1(odd ? l1[mm][0] : l1[mm][1]);
                    const u32x4 a0 = odd ? ar : l0[mm][0], a1 = odd ? l0[mm][1] : ar, d0 = odd ? dr : l1[mm][0], d1 = odd ? l1[mm][1] : dr;
                    u32x4 wout[2];
#pragma unroll
                    for (int bj = 0; bj < 2; ++bj) {
                        const u32x4 a = bj ? a1 : a0, d = bj ? d1 : d0;
                        f32x4 v0 = acc[ai][bj][m][0], v1 = acc[ai][bj][m][1];
                        v0[0] *= bf_lo(a.x) * __builtin_amdgcn_rcpf(bf_lo(d.x)); v0[1] *= bf_hi(a.x) * __builtin_amdgcn_rcpf(bf_hi(d.x)); v0[2] *= bf_lo(a.y) * __builtin_amdgcn_rcpf(bf_lo(d.y)); v0[3] *= bf_hi(a.y) * __builtin_amdgcn_rcpf(bf_hi(d.y));
                        v1[0] *= bf_lo(a.z) * __builtin_amdgcn_rcpf(bf_lo(d.z)); v1[1] *= bf_hi(a.z) * __builtin_amdgcn_rcpf(bf_hi(d.z)); v1[2] *= bf_lo(a.w) * __builtin_amdgcn_rcpf(bf_lo(d.w)); v1[3] *= bf_hi(a.w) * __builtin_amdgcn_rcpf(bf_hi(d.w));
                        acc[ai][bj][m][0] = v0; acc[ai][bj][m][1] = v1;
                        wout[bj] = pack8(v0, v1);
                    }
                    if (b == 3) { const u32x4 rv = EpiInProj::swap1(odd ? wout[0] : wout[1]);
                        bf16_t* rp = MG + (rowe + ai * 128 + m * 16) * DM + cw;
                        *(u32x4*)rp = odd ? rv : wout[0]; *(u32x4*)(rp + DM) = odd ? wout[1] : rv; }
                }
                asm volatile("" ::: "memory");
            }
        return b < 3;
    }
};
struct EpiResid {
    const bf16_t* X; bf16_t* Z;
    __device__ __forceinline__ bool operator()(f32x4 (&acc)[2][2][4][2], const Unit& u, int wr, int wc, int fr_, int fq) const {
        int fr = fr_; asm volatile("" : "+v"(fr));
        const bool odd = (fr & 1) != 0;
        const size_t off0 = (size_t)(u.pm * 256 + wr * 64 + (fr & ~1)) * DM + u.pn * 256 + wc * 64 + 8 * fq + (odd ? 32 : 0);
#pragma unroll
        for (int ai = 0; ai < 2; ++ai) {
            u32x4 xl[4][2];
#pragma unroll
            for (int m = 0; m < 4; ++m)
#pragma unroll
                for (int par = 0; par < 2; ++par) xl[m][par] = *(const u32x4*)(X + off0 + (size_t)(ai * 128 + m * 16 + par) * DM);
            asm volatile("" ::: "memory");
#pragma unroll
            for (int m = 0; m < 4; ++m) {
                const u32x4 xr = EpiInProj::swap1(odd ? xl[m][0] : xl[m][1]);
                const u32x4 x0 = odd ? xr : xl[m][0], x1 = odd ? xl[m][1] : xr;
                u32x4 wout[2];
#pragma unroll
                for (int bj = 0; bj < 2; ++bj) { const u32x4 x = bj ? x1 : x0;
                    f32x4 z0 = acc[ai][bj][m][0], z1 = acc[ai][bj][m][1];
                    z0[0] += ALPHA * bf_lo(x.x); z0[1] += ALPHA * bf_hi(x.x); z0[2] += ALPHA * bf_lo(x.y); z0[3] += ALPHA * bf_hi(x.y);
                    z1[0] += ALPHA * bf_lo(x.z); z1[1] += ALPHA * bf_hi(x.z); z1[2] += ALPHA * bf_lo(x.w); z1[3] += ALPHA * bf_hi(x.w);
                    wout[bj] = pack8(z0, z1); }
                const u32x4 rv = EpiInProj::swap1(odd ? wout[0] : wout[1]);
                bf16_t* rp = Z + off0 + (size_t)(ai * 128 + m * 16) * DM;
                *(u32x4*)rp = odd ? rv : wout[0]; *(u32x4*)(rp + DM) = odd ? wout[1] : rv; }
            asm volatile("" ::: "memory");
        }
        return false;
    }
};
struct EpiSwiGLU {
    bf16_t* HID;
    __device__ __forceinline__ bool operator()(f32x4 (&acc)[2][2][4][2], const Unit& u, int wr, int wc, int fr, int fq) const {
        char* hb = (char*)HID + ((size_t)((u.pm * 16 + wr * 4) * 64 + u.pn * 4 + wc) * 1024) + (fr * 64 + ((fq ^ ((fr >> 3) << 1)) * 16));
        EPI_ROWS_BEGIN
            f32x4 g0 = acc[ai][0][m][0], g1 = acc[ai][0][m][1]; const f32x4 u0 = acc[ai][1][m][0], u1 = acc[ai][1][m][1];
#pragma unroll
            for (int j = 0; j < 4; ++j) { g0[j] = g0[j] * fast_sigmoid(g0[j]) * u0[j]; g1[j] = g1[j] * fast_sigmoid(g1[j]) * u1[j]; }
            (void)row; __builtin_nontemporal_store(pack8(g0, g1), (u32x4*)(hb + (size_t)((ai * 8 + m) * 64) * 1024));
        EPI_ROWS_END
            return false;
    }
};
struct EpiRowScale {    static constexpr int NST = 16;
    bf16_t* YO; const float* gate;
    __device__ __forceinline__ bool operator()(f32x4 (&acc)[2][2][4][2], const Unit& u, int wr, int wc, int fr_, int fq) const {
        int fr = fr_; asm volatile("" : "+v"(fr));
        const bool odd = (fr & 1) != 0;
        const int cw = u.pn * 256 + wc * 64 + 8 * fq + (odd ? 32 : 0);
        float g8[2][4];
#pragma unroll
        for (int ai = 0; ai < 2; ++ai)
#pragma unroll
            for (int m = 0; m < 4; ++m) g8[ai][m] = gate[u.pm * 256 + ai * 128 + wr * 64 + m * 16 + fr];
        asm volatile("" ::: "memory");
        bf16_t* base = YO + (size_t)(u.pm * 256 + wr * 64 + (fr & ~1)) * DM + cw;
#pragma unroll
        for (int ai = 0; ai < 2; ++ai)
#pragma unroll
            for (int m = 0; m < 4; ++m) { const float g = g8[ai][m];
                const u32x4 w0 = pack8(acc[ai][0][m][0] * g, acc[ai][0][m][1] * g), w1 = pack8(acc[ai][1][m][0] * g, acc[ai][1][m][1] * g);
                const u32x4 send = odd ? w0 : w1, recv = EpiInProj::swap1(send);
                bf16_t* rp = base + (size_t)(ai * 128 + m * 16) * DM;
                *(u32x4*)rp = odd ? recv : w0; *(u32x4*)(rp + DM) = odd ? w1 : recv; }
        return false;
    }
};
struct EpiPle {
    bf16_t* SC; const bf16_t* X; bf16_t* Z;
    __device__ __forceinline__ bool operator()(f32x4 (&acc)[2][2][4][2], const Unit& u, int wr, int wc, int fr_, int fq) const {
        int fr = fr_; asm volatile("" : "+v"(fr));
        const int tag = u.tag;
        u32x4* scp = (u32x4*)SC + ((size_t)((u.pm * 4 + u.pn) * 8 + wr * 4 + wc) * 16) * 64 + (fq * 16 + fr);
        if (tag == 0) {
#pragma unroll
            for (int ai = 0; ai < 2; ++ai)
#pragma unroll
                for (int m = 0; m < 4; ++m)
#pragma unroll
                    for (int bj = 0; bj < 2; ++bj) {
                        f32x4 v0 = acc[ai][bj][m][0], v1 = acc[ai][bj][m][1];
#pragma unroll
                        for (int j = 0; j < 4; ++j) { v0[j] = fast_sigmoid(v0[j]); v1[j] = fast_sigmoid(v1[j]); }
                        scp[(ai * 8 + m * 2 + bj) * 64] = pack8(v0, v1);
                    }
            return false;
        }
        const bool odd = (fr & 1) != 0;
        const size_t off0 = (size_t)(u.pm * 256 + wr * 64 + (fr & ~1)) * DM + u.pn * 256 + wc * 64 + 8 * fq + (odd ? 32 : 0);
#pragma unroll
        for (int ai = 0; ai < 2; ++ai) {
            u32x4 sv[4][2], xl[4][2];
#pragma unroll
            for (int m = 0; m < 4; ++m)
#pragma unroll
                for (int k = 0; k < 2; ++k) { sv[m][k] = scp[(ai * 8 + m * 2 + k) * 64]; xl[m][k] = *(const u32x4*)(X + off0 + (size_t)(ai * 128 + m * 16 + k) * DM); }
            asm volatile("" ::: "memory");
#pragma unroll
            for (int m = 0; m < 4; ++m) {
                const u32x4 xr = EpiInProj::swap1(odd ? xl[m][0] : xl[m][1]);
                const u32x4 x0 = odd ? xr : xl[m][0], x1 = odd ? xl[m][1] : xr;
                u32x4 wout[2];
#pragma unroll
                for (int bj = 0; bj < 2; ++bj) { const u32x4 x = bj ? x1 : x0, sw = sv[m][bj];
                    const f32x4 v0 = acc[ai][bj][m][0], v1 = acc[ai][bj][m][1];
                    f32x4 z0, z1;
                    z0[0] = ALPHA * bf_lo(x.x) + bf_lo(sw.x) * v0[0]; z0[1] = ALPHA * bf_hi(x.x) + bf_hi(sw.x) * v0[1]; z0[2] = ALPHA * bf_lo(x.y) + bf_lo(sw.y) * v0[2]; z0[3] = ALPHA * bf_hi(x.y) + bf_hi(sw.y) * v0[3];
                    z1[0] = ALPHA * bf_lo(x.z) + bf_lo(sw.z) * v1[0]; z1[1] = ALPHA * bf_hi(x.z) + bf_hi(sw.z) * v1[1]; z1[2] = ALPHA * bf_lo(x.w) + bf_lo(sw.w) * v1[2]; z1[3] = ALPHA * bf_hi(x.w) + bf_hi(sw.w) * v1[3];
                    wout[bj] = pack8(z0, z1); }
                const u32x4 rv = EpiInProj::swap1(odd ? wout[0] : wout[1]);
                bf16_t* rp = Z + off0 + (size_t)(ai * 128 + m * 16) * DM;
                *(u32x4*)rp = odd ? rv : wout[0]; *(u32x4*)(rp + DM) = odd ? wout[1] : rv; }
            asm volatile("" ::: "memory");
        }
        return false;
    }
};
}

namespace att {
constexpr int KCH = 1040, KSLOT = 8 * KCH;
constexpr int VDQ = 4160, VSLOT = 4 * VDQ;
constexpr int L_K = 0, L_V = 3 * KSLOT, L_WS = L_V + 4 * VSLOT, L_TAB = L_WS + 8 * 256;
constexpr float NEG_BIG = -1e30f;
__device__ __forceinline__ int crow(int r, int hi) { return (r & 3) + 8 * (r >> 2) + 4 * hi; }
__device__ __forceinline__ float swap32(float v) { auto rr = __builtin_amdgcn_permlane32_swap(__float_as_uint(v), __float_as_uint(v), false, false); return __uint_as_float(rr[0] == __float_as_uint(v) ? rr[1] : rr[0]); }
__device__ __forceinline__ float xhalf_max(float v) { auto rr = __builtin_amdgcn_permlane32_swap(__float_as_uint(v), __float_as_uint(v), false, false); return fmaxf(__uint_as_float(rr[0]), __uint_as_float(rr[1])); }
__device__ __forceinline__ float xhalf_sum(float v) { auto rr = __builtin_amdgcn_permlane32_swap(__float_as_uint(v), __float_as_uint(v), false, false); return __uint_as_float(rr[0]) + __uint_as_float(rr[1]); }
__device__ __forceinline__ s16x4 vtr(LAS const char* p) { typedef short v4i16_t __attribute__((ext_vector_type(4))); return __builtin_bit_cast(s16x4, __builtin_amdgcn_ds_read_tr16_b64_v4i16((LAS v4i16_t*)p)); }
__device__ __forceinline__ int t5_bucket(int rel) {
    const int n = rel < 0 ? -rel : rel; int b;
    if (n < 8) b = n; else b = n >= 559 ? 15 : n >= 305 ? 14 : n >= 166 ? 13 : n >= 91 ? 12 : n >= 50 ? 11 : n >= 27 ? 10 : n >= 15 ? 9 : 8;
    return b + (rel > 0 ? 16 : 0);
}

struct ModNone {
    __device__ __forceinline__ bool active(int) const { return true; }
    __device__ __forceinline__ int tile_code(int) const { return 0; }
    __device__ __forceinline__ float code_const(int) const { return 0.f; }
    __device__ __forceinline__ void apply(f32x16&, f32x16&, int) const {}
};
struct ModD {
    LAS const float* tb; int q, qw0, hi; float cneg, cpos;
    __device__ __forceinline__ bool active(int) const { return true; }
    __device__ __forceinline__ int tile_code(int t) const { const int kv0 = t * 64; return (kv0 + 63 - qw0 <= -559) ? 1 : ((kv0 - (qw0 + 31) >= 559) ? 2 : 0); }
    __device__ __forceinline__ float code_const(int c) const { return c == 1 ? cneg : (c == 2 ? cpos : 0.f); }
    __device__ __forceinline__ void apply(f32x16& p0, f32x16& p1, int t) const {
        const int kv0 = t * 64;
        if (!(kv0 + 63 - qw0 <= -559) && !(kv0 - (qw0 + 31) >= 559)) {
            int base = kv0 - q + 1024 + 4 * hi; asm volatile("" : "+v"(base));
            const LAS float* tp = tb + base;
#pragma unroll
            for (int r = 0; r < 16; ++r) { p0[r] += tp[(r & 3) + 8 * (r >> 2)]; p1[r] += tp[(r & 3) + 8 * (r >> 2) + 32]; }
        }
    }
};
template <int SH> struct ModC {
    LAS const float* tc; int q, qw0, hi;
    static constexpr int SPAN = 64 << SH, MSK = (1 << SH) - 1;
    __device__ __forceinline__ bool active(int t) const { const int kv0 = t * 64; return (kv0 + 63 >= qw0 - SPAN) && (kv0 <= qw0 + 31 + SPAN); }
    __device__ __forceinline__ int tile_code(int) const { return 0; }
    __device__ __forceinline__ float code_const(int) const { return 0.f; }
    __device__ __forceinline__ void apply(f32x16& p0, f32x16& p1, int t) const {
        const int kv0 = t * 64;
        int base = kv0 - q + 4 * hi; asm volatile("" : "+v"(base));
        const LAS float* tp = tc + ((base >> SH) + 192);
        const int bm = base & MSK;
        const bool inner = (kv0 >= qw0 + 31 - SPAN) && (kv0 + 63 <= qw0 + SPAN);
        if (inner) {
#pragma unroll
            for (int r = 0; r < 16; ++r) {
                constexpr int dummy = 0; (void)dummy;
                const int K0 = (r & 3) + 8 * (r >> 2), K1 = K0 + 32;
                const int C0 = (K0 >> SH) + ((K0 & MSK) ? 1 : 0), C1 = (K1 >> SH) + ((K1 & MSK) ? 1 : 0);
                const bool ok0 = bm == ((-K0) & MSK), ok1 = bm == ((-K1) & MSK);
                const float b0 = tp[C0], b1 = tp[C1];
                p0[r] = ok0 ? p0[r] + b0 : -INFINITY; p1[r] = ok1 ? p1[r] + b1 : -INFINITY;
            }
        } else {
            const int bs = base + SPAN;
#pragma unroll
            for (int r = 0; r < 16; ++r) {
                const int K0 = (r & 3) + 8 * (r >> 2), K1 = K0 + 32;
                const int C0 = (K0 >> SH) + ((K0 & MSK) ? 1 : 0), C1 = (K1 >> SH) + ((K1 & MSK) ? 1 : 0);
                const bool ok0 = (bm == ((-K0) & MSK)) && ((unsigned)(bs + K0) <= (unsigned)(2 * SPAN)), ok1 = (bm == ((-K1) & MSK)) && ((unsigned)(bs + K1) <= (unsigned)(2 * SPAN));
                const float b0 = tp[C0], b1 = tp[C1];
                p0[r] = ok0 ? p0[r] + b0 : -INFINITY; p1[r] = ok1 ? p1[r] + b1 : -INFINITY;
            }
        }
    }
};
struct ModA {
    LAS const float* tab; int r, rs, w  , cb  ;
    __device__ __forceinline__ bool active(int t) const { return t >= rs && t < rs + 8; }
    __device__ __forceinline__ int tile_code(int) const { return 0; }
    __device__ __forceinline__ float code_const(int) const { return 0.f; }
    __device__ __forceinline__ void apply(f32x16& p0, f32x16& p1, int t) const {
        int base = (t - r + 7) * 128 + cb; asm volatile("" : "+v"(base));
        const LAS float* tp = tab + base;
#pragma unroll
        for (int i = 0; i < 16; ++i) {
            const int K0 = (i & 3) + 8 * (i >> 2), K1 = K0 + 32;
            const bool ok0 = (unsigned)(K0 - w) < 16u, ok1 = (unsigned)(K1 - w) < 16u;
            const float b0 = tp[K0], b1 = tp[K1];
            p0[i] = ok0 ? p0[i] + b0 : -INFINITY; p1[i] = ok1 ? p1[i] + b1 : -INFINITY;
        }
    }
};

#define ATT_WAITV(n) asm volatile("s_waitcnt vmcnt(" #n ")" ::: "memory")
#define ATT_BAR() do { asm volatile("s_waitcnt lgkmcnt(0)" ::: "memory"); __builtin_amdgcn_s_barrier(); asm volatile("" ::: "memory"); } while (0)
__device__ __forceinline__ void glds16(const void* gsrc, unsigned lds_dst) {
    asm volatile("s_mov_b32 m0, %1\n\ts_nop 0\n\tglobal_load_lds_dwordx4 %0, off" : : "v"(gsrc), "s"(lds_dst) : "memory", "m0"); }
__device__ __forceinline__ void glds16s(unsigned voff, const void* sbase, unsigned lds_dst) {
    asm volatile("s_mov_b32 m0, %2\n\ts_nop 0\n\tglobal_load_lds_dwordx4 %0, %1" : : "v"(voff), "s"(sbase), "s"(lds_dst) : "memory", "m0"); }
__device__ __forceinline__ void glds16s_o128(unsigned voff, const void* sbase, unsigned lds_dst) {
    asm volatile("s_mov_b32 m0, %2\n\ts_nop 0\n\tglobal_load_lds_dwordx4 %0, %1 offset:128" : : "v"(voff), "s"(sbase), "s"(lds_dst) : "memory", "m0"); }
constexpr int L_SIDE = 102400;
struct SideNone { static constexpr bool ON = false; };
struct SideConv { static constexpr bool ON = true; const float* eg; const float* eu; const float* ed; unsigned char* ws; int g; };
struct SideTile { const char* src; char* dst; int sh_src, sh_dst; };
__device__ __forceinline__ SideTile side_tile(const SideConv& s, int g) {
    const int which = g >> 13, e = (g >> 9) & 15, r = g & 511;
    SideTile T;
    if (which < 2) { const int kb = r >> 5, n0 = (r & 31) * 64;
        const float* base = which ? s.eu : s.eg;
        T.src = (const char*)(base + ((size_t)e * DM + kb * 64) * FF + n0); T.sh_src = 13;
        const int row0 = e * 4096 + (n0 >> 7) * 256 + which * 128 + (n0 & 127);
        T.dst = (char*)(s.ws + WS_WGU) + ((size_t)row0 * DM + kb * 64) * 2; T.sh_dst = 11; }
    else { const int kb = r >> 4, n0 = (r & 15) * 64;
        T.src = (const char*)(s.ed + ((size_t)e * FF + kb * 64) * DM + n0); T.sh_src = 12;
        T.dst = (char*)(s.ws + WS_WD) + ((size_t)(e * DM + n0) * FF + kb * 64) * 2; T.sh_dst = 12; }
    return T;
}
__device__ __forceinline__ void side_issue(const SideTile& T, unsigned lds0, int wid, int lane) {
    const unsigned kk = (unsigned)(8 * wid + (lane >> 4));
    const unsigned j16 = (unsigned)(((lane & 15) ^ (2 * wid)) * 16);
    glds16s((kk << T.sh_src) + j16, T.src, lds0 + L_SIDE + (2 * wid) * 1024);
    glds16s(((kk + 4) << T.sh_src) + j16, T.src, lds0 + L_SIDE + (2 * wid + 1) * 1024);
}
__device__ __forceinline__ void side_consume(const SideTile& T, LAS char* shm, int wid, int lane) {
    const int c = lane & 7, nn = lane >> 3;
    LAS const float* sp = (LAS const float*)(shm + L_SIDE + c * 2048 + (((2 * wid + (nn >> 2)) ^ (2 * c)) * 16) + (nn & 3) * 4);
    const float f0 = sp[0], f1 = sp[64], f2 = sp[128], f3 = sp[192], f4 = sp[256], f5 = sp[320], f6 = sp[384], f7 = sp[448];
    u32x4 o; o.x = cvt_pk_bf16(f0, f1); o.y = cvt_pk_bf16(f2, f3); o.z = cvt_pk_bf16(f4, f5); o.w = cvt_pk_bf16(f6, f7);
    __builtin_nontemporal_store(o, (u32x4*)(T.dst + ((size_t)(8 * wid + nn) << T.sh_dst) + 16 * c));
}
template <int DV>
__device__ __forceinline__ void attn_pre(LAS char* shm, const bf16_t* Kp, const bf16_t* Vp, int t0, int t1, int wid, int lane, const int rsh = 0) {
    if (t0 >= t1) return;
    const unsigned kvoff = (unsigned)(((lane * HW) << rsh) + wid * 8) * 2u;
    const unsigned vvoff = (unsigned)(((((wid & 3) * 16 + (lane >> 2)) * HW) << rsh) + (wid >> 2) * 32 + (lane & 3) * 8) * 2u;
    const unsigned lds0 = (unsigned)(uintptr_t)shm;
    const unsigned kdst = lds0 + L_K + wid * KCH, vdst = lds0 + L_V + (wid >> 2) * VDQ + (wid & 3) * 1024;
    asm volatile("s_waitcnt vmcnt(0)" ::: "memory");
    ATT_BAR();
    const int tl = t1 - 1, tb = t0 + 1 < tl ? t0 + 1 : tl;
    const size_t ta_ = ((size_t)t0 * (64 * HW * 2)) << rsh, tb_ = ((size_t)tb * (64 * HW * 2)) << rsh;
    glds16s(kvoff, (const char*)Kp + ta_, kdst); glds16s(vvoff, (const char*)Vp + ta_, vdst);
    if (DV == 128) glds16s(vvoff, (const char*)Vp + ta_ + 128, vdst + 2 * VDQ);
    glds16s(kvoff, (const char*)Kp + tb_, kdst + KSLOT); glds16s(vvoff, (const char*)Vp + tb_, vdst + VSLOT);
    if (DV == 128) glds16s(vvoff, (const char*)Vp + tb_ + 128, vdst + 2 * VDQ + VSLOT);
}
template <int DV, class Mod, class Side = SideNone, bool PRE = false>
__device__ __forceinline__ void attn_pass(LAS char* shm, const bf16_t* Kp, const bf16_t* Vp, int t0, int t1, const bf16x8 (&q)[4], const Mod& mod, float& mhat, float& lsum, bool& unset, f32x16 (&o)[DV / 32], int tid, int wid, int lane, int grp, const Side& side = Side{}, const int rsh = 0  ) {
    static_assert(!Side::ON || DV == 64, "the side stream's counted waits are written for the 64-wide pass");
    constexpr bool FOLD = true;
    const int r32 = lane & 31, hi = lane >> 5;
    if (t0 >= t1) return;
    LAS float* wsf = (LAS float*)(shm + L_WS) + wid * 64;
    const int kfo = hi * KCH + r32 * 16;
    const int vlo = ((lane >> 4) & 1) * 32 + (lane & 3) * 8 + (4 * hi + ((lane & 15) >> 2)) * 64;
    const unsigned kvoff = (unsigned)(((lane * HW) << rsh) + wid * 8) * 2u;
    const unsigned vvoff = (unsigned)(((((wid & 3) * 16 + (lane >> 2)) * HW) << rsh) + (wid >> 2) * 32 + (lane & 3) * 8) * 2u;
    const unsigned lds0 = (unsigned)(uintptr_t)shm;
    const unsigned kdst = lds0 + L_K + wid * KCH, vdst = lds0 + L_V + (wid >> 2) * VDQ + (wid & 3) * 1024;
#define ATT_DMA(t_, ko_, vo_) do { const size_t to_ = ((size_t)(t_) * (64 * HW * 2)) << rsh;         \
        glds16s(kvoff, (const char*)Kp + to_, kdst + (ko_)); \
        glds16s(vvoff, (const char*)Vp + to_, vdst + (vo_)); \
        if (DV == 128) glds16s(vvoff, (const char*)Vp + to_ + 128, vdst + 2 * VDQ + (vo_)); } while (0)
#define ATT_WAIT_TILE() do { if (DV == 128) ATT_WAITV(3); else ATT_WAITV(2); } while (0)
#define ATT_SB() __builtin_amdgcn_sched_barrier(0)
#define ATT_KLD(ko_) do { LAS const char* kp_ = shm + L_K + (ko_) + kfo; \
        _Pragma("unroll") for (int d0 = 0; d0 < 4; ++d0) { kf[2 * d0] = *(LAS const bf16x8*)(kp_ + d0 * 2 * KCH); kf[2 * d0 + 1] = *(LAS const bf16x8*)(kp_ + d0 * 2 * KCH + 512); } } while (0)
#define ATT_QKM() do { \
        if (FOLD) { p0 = __builtin_amdgcn_mfma_f32_32x32x16_bf16(kf[0], q[0], negm, 0, 0, 0); p1 = __builtin_amdgcn_mfma_f32_32x32x16_bf16(kf[1], q[0], negm, 0, 0, 0); } \
        else { p0 = __builtin_amdgcn_mfma_f32_32x32x16_bf16(kf[0], q[0], f32x16{}, 0, 0, 0); p1 = __builtin_amdgcn_mfma_f32_32x32x16_bf16(kf[1], q[0], f32x16{}, 0, 0, 0); } \
        _Pragma("unroll") for (int d0 = 1; d0 < 4; ++d0) { p0 = __builtin_amdgcn_mfma_f32_32x32x16_bf16(kf[2 * d0], q[d0], p0, 0, 0, 0); p1 = __builtin_amdgcn_mfma_f32_32x32x16_bf16(kf[2 * d0 + 1], q[d0], p1, 0, 0, 0); } } while (0)
#define ATT_VLD(dst_, dq_) do { _Pragma("unroll") for (int kc = 0; kc < 4; ++kc) { const s16x4 lo_ = vtr(vp + (dq_) * VDQ + kc * 1024), hh_ = vtr(vp + (dq_) * VDQ + kc * 1024 + 512); \
        dst_[kc] = (bf16x8){lo_[0], lo_[1], lo_[2], lo_[3], hh_[0], hh_[1], hh_[2], hh_[3]}; } } while (0)
#define ATT_PVM(src_, dq_) do { _Pragma("unroll") for (int kc = 0; kc < 4; ++kc) o[dq_] = __builtin_amdgcn_mfma_f32_32x32x16_bf16(__builtin_bit_cast(bf16x8, pw[kc]), src_[kc], o[dq_], 0, 0, 0); } while (0)
    const int tl = t1 - 1;
    if constexpr (!PRE) {
    asm volatile("s_waitcnt vmcnt(0)" ::: "memory");
    ATT_BAR();
    ATT_DMA(t0, 0, 0);
    ATT_DMA((t0 + 1 < tl ? t0 + 1 : tl), KSLOT, VSLOT);
    }
    ATT_WAIT_TILE();
    ATT_BAR();
    if (grp == 1) ATT_BAR();
    u32x4 pw[4];
    f32x16 negm, p0, p1;
    bf16x8 kf[8], va[4], vb[4];
    float cfold = 0.f; int ccode = 0;
#pragma unroll
    for (int r = 0; r < 16; ++r) negm[r] = -mhat;
#define ATT_CFOLD(t_) do { const int cn_ = mod.tile_code(t_); if (cn_ != ccode) { ccode = cn_; cfold = mod.code_const(cn_); _Pragma("unroll") for (int r = 0; r < 16; ++r) negm[r] = cfold - mhat; } } while (0)
    { ATT_DMA((t0 + 2 < tl ? t0 + 2 : tl), 2 * KSLOT, 2 * VSLOT);
      if (mod.active(t0)) { ATT_CFOLD(t0); ATT_KLD(0); ATT_QKM(); asm volatile("" : "+v"(p0), "+v"(p1)); }
      ATT_WAIT_TILE();
      ATT_SB(); ATT_BAR(); ATT_SB(); }
    int ko = 0, vo = 0;
    int sg = 0; if constexpr (Side::ON) sg = side.g;
    for (int t = t0; t < t1; ++t) {
        const bool act = mod.active(t);
        if (act) {
            mod.apply(p0, p1, t);
            float mx = __builtin_fmaxf(__builtin_fmaxf(p0[0], p1[0]), p0[1]);
            mx = __builtin_fmaxf(mx, p1[1]);
#pragma unroll
            for (int r = 2; r < 16; ++r) mx = __builtin_fmaxf(__builtin_fmaxf(mx, p0[r]), p1[r]);
            mx = xhalf_max(mx);
            const bool lane_resc = (mx > 8.0f) || (unset && mx > -INFINITY);
            if (__any(lane_resc)) {
                const float dl = lane_resc ? (unset ? mx : __builtin_fmaxf(mx, 0.f)) : 0.f;
                const float f = unset ? 0.f : __builtin_amdgcn_exp2f(-dl);
                mhat += dl; lsum *= f; unset = unset && !lane_resc;
#pragma unroll
                for (int r = 0; r < 16; ++r) { p0[r] -= dl; p1[r] -= dl; negm[r] = cfold - mhat; }
                if (hi == 0) wsf[r32] = f;
#pragma unroll
                for (int r = 0; r < 16; ++r) { const float fr_ = wsf[crow(r, hi)];
#pragma unroll
                    for (int dq = 0; dq < DV / 32; ++dq) o[dq][r] *= fr_; }
            }
            float sacc = 0.f;
#pragma unroll
            for (int r = 0; r < 16; ++r) { p0[r] = __builtin_amdgcn_exp2f(p0[r]); p1[r] = __builtin_amdgcn_exp2f(p1[r]); sacc += p0[r] + p1[r]; }
            lsum += sacc;
#pragma unroll
            for (int j = 0; j < 4; ++j) { pw[0][j] = cvt_pk_bf16(p0[2 * j], p0[2 * j + 1]); pw[1][j] = cvt_pk_bf16(p0[8 + 2 * j], p0[8 + 2 * j + 1]); pw[2][j] = cvt_pk_bf16(p1[2 * j], p1[2 * j + 1]); pw[3][j] = cvt_pk_bf16(p1[8 + 2 * j], p1[8 + 2 * j + 1]); }
            asm volatile("" : "+v"(pw[0]), "+v"(pw[1]), "+v"(pw[2]), "+v"(pw[3]), "+v"(lsum));
        }
        ATT_SB(); ATT_BAR(); ATT_SB();
        const int ko1 = ko == 2 * KSLOT ? 0 : ko + KSLOT;
        const int vom = vo == 0 ? 3 * VSLOT : vo - VSLOT;
        ATT_DMA((t + 3 < tl ? t + 3 : tl), ko, vom);
        const int sph = Side::ON ? ((t - t0) & 3) : 0;
        if constexpr (Side::ON) { if (sph == 0) { const SideTile T_ = side_tile(side, sg); side_issue(T_, lds0, wid, lane); } }
        const bool doqk = (t + 1 < t1) && mod.active(t + 1);
        LAS const char* vp = shm + L_V + vo + vlo;
        if (doqk) ATT_CFOLD(t + 1);
        if (true) {
            if (doqk) { LAS const char* kp_ = shm + L_K + ko1 + kfo;
#pragma unroll
                for (int d0 = 0; d0 < 2; ++d0) { kf[2 * d0] = *(LAS const bf16x8*)(kp_ + d0 * 2 * KCH); kf[2 * d0 + 1] = *(LAS const bf16x8*)(kp_ + d0 * 2 * KCH + 512); } }
            if (act) ATT_VLD(va, 0);
            ATT_SB();
            if (doqk) { LAS const char* kp_ = shm + L_K + ko1 + kfo;
                p0 = __builtin_amdgcn_mfma_f32_32x32x16_bf16(kf[0], q[0], negm, 0, 0, 0); p1 = __builtin_amdgcn_mfma_f32_32x32x16_bf16(kf[1], q[0], negm, 0, 0, 0);
                p0 = __builtin_amdgcn_mfma_f32_32x32x16_bf16(kf[2], q[1], p0, 0, 0, 0); p1 = __builtin_amdgcn_mfma_f32_32x32x16_bf16(kf[3], q[1], p1, 0, 0, 0);
#pragma unroll
                for (int d0 = 2; d0 < 4; ++d0) { kf[2 * d0] = *(LAS const bf16x8*)(kp_ + d0 * 2 * KCH); kf[2 * d0 + 1] = *(LAS const bf16x8*)(kp_ + d0 * 2 * KCH + 512); } }
            ATT_SB();
            if (doqk) {
#pragma unroll
                for (int d0 = 2; d0 < 4; ++d0) { p0 = __builtin_amdgcn_mfma_f32_32x32x16_bf16(kf[2 * d0], q[d0], p0, 0, 0, 0); p1 = __builtin_amdgcn_mfma_f32_32x32x16_bf16(kf[2 * d0 + 1], q[d0], p1, 0, 0, 0); } }
        } else {
            if (doqk) ATT_KLD(ko1);
            if (act) ATT_VLD(va, 0);
            ATT_SB();
            if (doqk) ATT_QKM();
        }
        if (act) {
            ATT_VLD(vb, 1); ATT_SB(); ATT_PVM(va, 0); ATT_SB();
            if (DV == 128) { ATT_VLD(va, 2); ATT_SB(); ATT_PVM(vb, 1); ATT_SB(); ATT_VLD(vb, 3); ATT_SB(); ATT_PVM(va, 2); ATT_SB(); ATT_PVM(vb, 3); }
            else ATT_PVM(vb, 1);
        }
        if constexpr (Side::ON) { if (sph == 3) { const SideTile T_ = side_tile(side, sg); side_consume(T_, shm, wid, lane); ++sg; } }
        ATT_SB();
        if (doqk) asm volatile("" : "+v"(p0), "+v"(p1));
        if (act) { asm volatile("" : "+v"(o[0]), "+v"(o[1])); if (DV == 128) asm volatile("" : "+v"(o[DV / 32 - 2]), "+v"(o[DV / 32 - 1])); }
        if constexpr (Side::ON) { if (sph <= 1) ATT_WAITV(4); else if (sph == 2) ATT_WAITV(2); else ATT_WAITV(3); }
        else ATT_WAIT_TILE();
        ATT_SB(); ATT_BAR(); ATT_SB();
        ko = ko1; vo = vo == 3 * VSLOT ? 0 : vo + VSLOT;
    }
    if (grp == 0) ATT_BAR();
#undef ATT_DMA
#undef ATT_KLD
#undef ATT_QKM
#undef ATT_VLD
#undef ATT_PVM
#undef ATT_WAIT_TILE
#undef ATT_CFOLD
}
__device__ __forceinline__ void load_q(bf16x8 (&q)[4], const bf16_t* Qrow0, int r32, int hi, int rsh = 0) {
#pragma unroll
    for (int d0 = 0; d0 < 4; ++d0) q[d0] = *(const bf16x8*)(Qrow0 + (unsigned)(((r32 * HW) << rsh) + d0 * 16 + hi * 8));
}
__device__ __forceinline__ void row_recip(float (&rl)[16], float lsum, LAS float* wsf, int r32, int hi) {
    const float lt = xhalf_sum(lsum);
    if (hi == 0) wsf[r32] = 1.0f / lt;
#pragma unroll
    for (int r = 0; r < 16; ++r) rl[r] = wsf[crow(r, hi)];
}
__device__ __forceinline__ int launder(int v) { asm volatile("" : "+v"(v)); return v; }
__device__ __forceinline__ float bperm_xor(float v, int lane, int off) { return __uint_as_float(__builtin_amdgcn_ds_bpermute((lane ^ off) << 2, __float_as_uint(v))); }
__device__ __forceinline__ bf16_t to_bf16(float v) { return (bf16_t)(cvt_pk_bf16(v, v) & 0xffffu); }
__device__ __forceinline__ void store_rows2(bf16_t* pA  , size_t offB  , float lo32  , float hi32  ) {
    auto sw = __builtin_amdgcn_permlane32_swap(__float_as_uint(lo32), __float_as_uint(hi32), false, false);
    pA[0] = to_bf16(__uint_as_float(sw[0])); pA[offB] = to_bf16(__uint_as_float(sw[1]));
}

__device__ __forceinline__ void unit_gqa(LAS char* shm, const bf16_t* H, bf16_t* YB, int u, int tid_, int wid_, int lane_, int grp, const SideConv& side) {
    int tid = tid_; asm volatile("" : "+v"(tid)); const int lane = tid & 63; const int wid = __builtin_amdgcn_readfirstlane(tid >> 6); (void)wid_; (void)lane_;
    const int qb = u & 31, bh = u >> 5, h = bh % 6, b = bh / 6, r32 = lane & 31, hi = lane >> 5;
    const bf16_t* Hb = H + (size_t)b * SEQ * HW;
    const int q0 = qb * 256 + wid * 32;
    bf16x8 q[4]; load_q(q, Hb + (size_t)q0 * HW + C_QB + h * 64, r32, hi);
    float mhat = 0.f, lsum = 0.f; bool unset = true; f32x16 o[2]; o[0] = f32x16{}; o[1] = f32x16{};
    ModNone mod;
    attn_pass<64, ModNone, SideConv>(shm, Hb + C_KB + (h / 3) * 64, Hb + C_VB + (h / 3) * 64, 0, SEQ / 64, q, mod, mhat, lsum, unset, o, tid, wid, lane, grp, side);
    float rl[16]; row_recip(rl, lsum, (LAS float*)(shm + L_WS) + wid * 64, r32, hi);
    unsigned yo = (unsigned)q0 * 384u + h * 64 + lane; asm volatile("" : "+v"(yo));
    bf16_t* Y = YB + (size_t)b * SEQ * 384 + yo;
#pragma unroll
    for (int r = 0; r < 16; ++r) store_rows2(Y + ((r & 3) + 8 * (r >> 2)) * 384, 4 * 384, o[0][r] * rl[r], o[1][r] * rl[r]);
}
__device__ __forceinline__ void unit_na(LAS char* shm, const bf16_t* H, bf16_t* YA, const float* rpb_h  , int u, int tid_, int wid_, int lane_, int grp) {
    int tid = tid_; asm volatile("" : "+v"(tid)); const int lane = tid & 63; const int wid = __builtin_amdgcn_readfirstlane(tid >> 6); (void)wid_; (void)lane_;
    const int qb = u & 31, bh = u >> 5, h = bh % 6, b = bh / 6, r32 = lane & 31, hi = lane >> 5;
    LAS float* tab = (LAS float*)(shm + L_TAB);
    const bf16_t* Hb = H + (size_t)b * SEQ * HW;
    { int tlo_ = qb * 4 - 4; tlo_ = tlo_ < 0 ? 0 : (tlo_ > 120 ? 120 : tlo_); int thi_ = qb * 4 + 3 - 4; thi_ = thi_ < 0 ? 0 : (thi_ > 120 ? 120 : thi_); thi_ += 8;
      attn_pre<64>(shm, Hb + C_KA + h * 64, Hb + C_VA + h * 64, tlo_, thi_, wid, lane); }
    for (int i = tid; i < 15 * 128; i += 512) { const int dr = i >> 7, dc = (i & 127) - 63 + 15; tab[i] = (dc >= 0 && dc <= 30) ? rpb_h[h * 465 + dr * 31 + dc] * LOG2E : 0.f; }
    __syncthreads();
    const int q0 = qb * 256 + wid * 32;
    const int r = qb * 4 + (wid >> 1), c = (wid & 1) * 32 + r32;
    ModA mod; mod.tab = tab; mod.r = r; mod.cb = 63 - c + 4 * hi;
    { int rs = r - 4; rs = rs < 0 ? 0 : (rs > 120 ? 120 : rs); mod.rs = rs; int cs = c - 8; cs = cs < 0 ? 0 : (cs > 48 ? 48 : cs); mod.w = cs - 4 * hi; }
    int tlo = qb * 4 - 4; tlo = tlo < 0 ? 0 : (tlo > 120 ? 120 : tlo);
    int thi = qb * 4 + 3 - 4; thi = thi < 0 ? 0 : (thi > 120 ? 120 : thi); thi += 8;
    bf16x8 q[4]; load_q(q, Hb + (size_t)q0 * HW + C_QA + h * 64, r32, hi);
    float mhat = 0.f, lsum = 0.f; bool unset = true; f32x16 o[2]; o[0] = f32x16{}; o[1] = f32x16{};
    attn_pass<64, ModA, SideNone, true>(shm, Hb + C_KA + h * 64, Hb + C_VA + h * 64, tlo, thi, q, mod, mhat, lsum, unset, o, tid, wid, lane, grp);
    float rl[16]; row_recip(rl, lsum, (LAS float*)(shm + L_WS) + wid * 64, r32, hi);
    unsigned yo = (unsigned)q0 * 384u + h * 64 + lane; asm volatile("" : "+v"(yo));
    bf16_t* Y = YA + (size_t)b * SEQ * 384 + yo;
#pragma unroll
    for (int rr = 0; rr < 16; ++rr) store_rows2(Y + ((rr & 3) + 8 * (rr >> 2)) * 384, 4 * 384, o[0][rr] * rl[rr], o[1][rr] * rl[rr]);
}
template <int G_>
__device__ __forceinline__ void dil_sub_pass(LAS char* shm, const bf16_t* Hb, LAS float* tab, const float* t5, int j, int s, float& mhat, float& lsum, bool& unset, f32x16 (&o)[2], int tid, int wid, int lane, int grp) {
    constexpr int SH = 2 * G_, NAB = 32 >> SH, SL = SEQ >> SH;
    const int r32 = lane & 31, hi = lane >> 5, head = 2 * G_ + j;
    const int rho = s / NAB, ablk = (s % NAB) * 256, a0 = ablk + wid * 32;
    int lo = ablk - 64; lo = lo < 0 ? 0 : lo; int hi_k = ablk + 255 + 64; hi_k = hi_k > SL - 1 ? SL - 1 : hi_k;
    const bf16_t* Hs = Hb + (size_t)rho * HW;
    attn_pre<64>(shm, Hs + C_KC + head * 64, Hs + C_VC + head * 64, lo >> 6, (hi_k >> 6) + 1, wid, lane, SH);
    for (int i = tid; i < 384; i += 512) { const int jj = i - 192; tab[i] = (jj >= -64 && jj <= 64) ? t5[t5_bucket(jj << SH) * 10 + head] * LOG2E : 0.f; }
    __syncthreads();
    ModC<0> mod; mod.tc = tab; mod.q = a0 + r32; mod.qw0 = a0; mod.hi = hi;
    bf16x8 q[4]; load_q(q, Hs + ((size_t)a0 << SH) * HW + C_QC + head * 64, r32, hi, SH);
    attn_pass<64, ModC<0>, SideNone, true>(shm, Hs + C_KC + head * 64, Hs + C_VC + head * 64, lo >> 6, (hi_k >> 6) + 1, q, mod, mhat, lsum, unset, o, tid, wid, lane, grp, SideNone{}, SH);
}
template <int G_>
__device__ __forceinline__ void unit_dil_part(LAS char* shm, const bf16_t* H, bf16_t* YC, float* LSEP, const float* t5, int u, int tid_, int grp) {
    constexpr int SH = 2 * G_, NAB = 32 >> SH;
    int tid = tid_; asm volatile("" : "+v"(tid)); const int lane = tid & 63; const int wid = __builtin_amdgcn_readfirstlane(tid >> 6);
    const int s = u & 31, bj = u >> 5, j = bj & 1, b = bj >> 1, r32 = lane & 31, hi = lane >> 5;
    const bf16_t* Hb = H + (size_t)b * SEQ * HW;
    float mhat = 0.f, lsum = 0.f; bool unset = true; f32x16 o[2]; o[0] = f32x16{}; o[1] = f32x16{};
    dil_sub_pass<G_>(shm, Hb, (LAS float*)(shm + L_TAB), t5, j, s, mhat, lsum, unset, o, tid, wid, lane, grp);
    const int rho = s / NAB, a0 = (s % NAB) * 256 + wid * 32;
    LAS float* wsf = (LAS float*)(shm + L_WS) + wid * 64;
    const float lt = xhalf_sum(lsum);
    if (hi == 0) { wsf[r32] = 1.0f / lt; LSEP[((size_t)(G_ - 1) * MTOK + (size_t)b * SEQ + rho + ((a0 + r32) << SH)) * 2 + j] = mhat + __builtin_amdgcn_logf(lt); }
    LDS_WAIT();
    float rl[16];
#pragma unroll
    for (int r = 0; r < 16; ++r) rl[r] = wsf[crow(r, hi)];
    unsigned yo = (unsigned)(rho + (a0 << SH)) * 256u + (G_ == 1 ? 128 : 0) + j * 64 + lane; asm volatile("" : "+v"(yo));
    bf16_t* Y = YC + (size_t)b * SEQ * 256 + yo;
#pragma unroll
    for (int rr = 0; rr < 16; ++rr) store_rows2(Y + (((rr & 3) + 8 * (rr >> 2)) << SH) * 256, (size_t)(4 << SH) * 256, o[0][rr] * rl[rr], o[1][rr] * rl[rr]);
}
__device__ __forceinline__ void unit_dil(LAS char* shm, const bf16_t* H, bf16_t* YC, const float* LSEP, const float* t5, int u, int tid_, int wid_, int lane_, int grp) {
    int tid = tid_; asm volatile("" : "+v"(tid)); const int lane = tid & 63; const int wid = __builtin_amdgcn_readfirstlane(tid >> 6); (void)wid_; (void)lane_;
    const int qb = u & 31, bj = u >> 5, j = bj & 1, b = bj >> 1, r32 = lane & 31, hi = lane >> 5;
    const bf16_t* Hb = H + (size_t)b * SEQ * HW;
    const int q0 = qb * 256 + wid * 32;
    float mhat = 0.f, lsum = 0.f; bool unset = true; f32x16 o[2]; o[0] = f32x16{}; o[1] = f32x16{};
    dil_sub_pass<0>(shm, Hb, (LAS float*)(shm + L_TAB), t5, j, qb, mhat, lsum, unset, o, tid, wid, lane, grp);
    LAS float* wsf = (LAS float*)(shm + L_WS) + wid * 64;
    const float lt = xhalf_sum(lsum);
    float w1 = 0.f, w2 = 0.f;
    if (hi == 0) { const size_t tk = ((size_t)b * SEQ + q0 + r32) * 2 + j;
        const float l0 = mhat + __builtin_amdgcn_logf(lt), l1 = LSEP[tk], l2 = LSEP[(size_t)MTOK * 2 + tk];
        const float mx = __builtin_fmaxf(__builtin_fmaxf(l0, l1), l2);
        const float e0 = __builtin_amdgcn_exp2f(l0 - mx), e1 = __builtin_amdgcn_exp2f(l1 - mx), e2 = __builtin_amdgcn_exp2f(l2 - mx);
        const float inv = 1.0f / (e0 + e1 + e2);
        wsf[r32] = e0 * inv / lt; w1 = e1 * inv; w2 = e2 * inv; }
    LDS_WAIT();
    float c0[16], c1[16], c2[16];
#pragma unroll
    for (int r = 0; r < 16; ++r) c0[r] = wsf[crow(r, hi)];
    LDS_WAIT();
    if (hi == 0) { wsf[r32] = w1; wsf[32 + r32] = w2; }
    LDS_WAIT();
#pragma unroll
    for (int r = 0; r < 16; ++r) { c1[r] = wsf[crow(r, hi)]; c2[r] = wsf[32 + crow(r, hi)]; }
    unsigned yo = (unsigned)(q0 + 4 * hi) * 256u + j * 64 + r32; asm volatile("" : "+v"(yo));
    bf16_t* Y = YC + (size_t)b * SEQ * 256 + yo;
#pragma unroll
    for (int rr = 0; rr < 16; ++rr) { float vv[2];
#pragma unroll
        for (int dq = 0; dq < 2; ++dq) { const bf16_t* yp = Y + ((rr & 3) + 8 * (rr >> 2)) * 256 + dq * 32;
            const float p2 = __uint_as_float((unsigned)yp[0] << 16), p1 = __uint_as_float((unsigned)yp[128] << 16);
            vv[dq] = o[dq][rr] * c0[rr] + c1[rr] * p1 + c2[rr] * p2; }
        bf16_t* ya = YC + (size_t)b * SEQ * 256 + (size_t)(q0 + (rr & 3) + 8 * (rr >> 2)) * 256 + j * 64 + lane;
        store_rows2(ya, 4 * 256, vv[0], vv[1]); ya[128] = 0; ya[128 + 4 * 256] = 0; }
}
template <int PASS> __device__ __forceinline__ void unit_diff(LAS char* shm, const bf16_t* H, bf16_t* YD, const float* t5, const float* lam_p  , const float* gain  , float lam_init, float* stash  , int u, int tid_, int wid_, int lane_, int grp) {
    int tid = tid_; asm volatile("" : "+v"(tid)); const int lane = tid & 63; const int wid = __builtin_amdgcn_readfirstlane(tid >> 6); (void)wid_; (void)lane_;
    const int qb = u & 31, bh = u >> 5, h = bh & 3, b = bh >> 2, r32 = lane & 31, hi = lane >> 5;
    LAS float* tab = (LAS float*)(shm + L_TAB);
    attn_pre<128>(shm, H + (size_t)b * SEQ * HW + C_KD + h * 128 + PASS * 64, H + (size_t)b * SEQ * HW + C_VD + h * 128, 0, SEQ / 64, wid, lane);
    for (int i = tid; i < 2049; i += 512) tab[i] = t5[t5_bucket(i - 1024) * 10 + 6 + h] * LOG2E;
    __syncthreads();
    const float lam = __expf(wave_sum(lam_p[lane] * lam_p[64 + lane])) - __expf(wave_sum(lam_p[128 + lane] * lam_p[192 + lane])) + lam_init;
    const bf16_t* Hb = H + (size_t)b * SEQ * HW;
    const int q0 = qb * 256 + wid * 32;
    ModD mod; mod.tb = tab; mod.q = q0 + r32; mod.qw0 = q0; mod.hi = hi; mod.cneg = __uint_as_float(__builtin_amdgcn_readfirstlane(__float_as_uint(tab[0]))); mod.cpos = __uint_as_float(__builtin_amdgcn_readfirstlane(__float_as_uint(tab[2048])));
    f32x16 o[4];
    { constexpr int pass = PASS;
        bf16x8 q[4]; load_q(q, Hb + (size_t)q0 * HW + C_QD + h * 128 + pass * 64, r32, hi);
        float mhat = 0.f, lsum = 0.f; bool unset = true;
#pragma unroll
        for (int dq = 0; dq < 4; ++dq) o[dq] = f32x16{};
        attn_pass<128, ModD, SideNone, true>(shm, Hb + C_KD + h * 128 + pass * 64, Hb + C_VD + h * 128, 0, SEQ / 64, q, mod, mhat, lsum, unset, o, tid, wid, lane, grp);
        float rl[16]; row_recip(rl, lsum, (LAS float*)(shm + L_WS) + wid * 64, r32, hi);
        const int lane2 = launder(lane);
        unsigned so = (unsigned)tid; asm volatile("" : "+v"(so));
        f32x4* st4 = (f32x4*)stash + so;
        if (pass == 0) {
#pragma unroll
            for (int dq = 0; dq < 4; ++dq)
#pragma unroll
                for (int r4 = 0; r4 < 4; ++r4) st4[(dq * 4 + r4) * 512] = (f32x4){o[dq][4 * r4] * rl[4 * r4], o[dq][4 * r4 + 1] * rl[4 * r4 + 1], o[dq][4 * r4 + 2] * rl[4 * r4 + 2], o[dq][4 * r4 + 3] * rl[4 * r4 + 3]};
        } else {
            float ss[16];
#pragma unroll
            for (int r = 0; r < 16; ++r) ss[r] = 0.f;
#pragma unroll
            for (int dq = 0; dq < 4; ++dq) {
                f32x4 s1[4];
#pragma unroll
                for (int r4 = 0; r4 < 4; ++r4) s1[r4] = st4[(dq * 4 + r4) * 512];
                asm volatile("" ::: "memory");
#pragma unroll
                for (int r4 = 0; r4 < 4; ++r4)
#pragma unroll
                    for (int k = 0; k < 4; ++k) { const int r = 4 * r4 + k; const float v = s1[r4][k] - lam * (o[dq][r] * rl[r]); o[dq][r] = v; ss[r] += v * v; }
                asm volatile("" ::: "memory"); }
#pragma unroll
            for (int r = 0; r < 16; ++r) {
#pragma unroll
                for (int off = 1; off < 32; off <<= 1) ss[r] += bperm_xor(ss[r], lane2, off);
                ss[r] = rsqrtf(ss[r] * (1.0f / 128.0f) + 1e-6f) * (1.0f - lam_init);
            }
            unsigned yo = (unsigned)(q0 + 4 * hi) * 512u + h * 128 + r32; asm volatile("" : "+v"(yo));
            bf16_t* Y = YD + (size_t)b * SEQ * 512 + yo;
#pragma unroll
            for (int dp = 0; dp < 2; ++dp) { const float g0 = gain[dp * 64 + r32], g1 = gain[dp * 64 + 32 + r32];
                bf16_t* ya = YD + (size_t)b * SEQ * 512 + (size_t)q0 * 512 + h * 128 + dp * 64 + lane;
#pragma unroll
                for (int r = 0; r < 16; ++r) store_rows2(ya + ((r & 3) + 8 * (r >> 2)) * 512, 4 * 512, o[2 * dp][r] * ss[r] * g0, o[2 * dp + 1][r] * ss[r] * g1); }
        }
    }
}
}

__device__ __forceinline__ void conv_item(const float* W, int srcN, int k0, int n0, bf16_t* WT, int dst_ld, int dst_row0, float scale, LAS float* scr, int lane) {
    float wv[32];
    const float* wp = W + (size_t)(k0 + (lane >> 5)) * srcN + n0 + (lane & 31);
#pragma unroll
    for (int i = 0; i < 32; ++i) wv[i] = __builtin_nontemporal_load(wp + (size_t)(2 * i) * srcN);
    asm volatile("" ::: "memory");
#pragma unroll
    for (int i = 0; i < 32; ++i) scr[(2 * i + (lane >> 5)) * 33 + (lane & 31)] = wv[i];
    LDS_WAIT(); asm volatile("" ::: "memory");
    const int c = lane & 7;
#pragma unroll
    for (int j = 0; j < 4; ++j) { const int n = (lane >> 3) + 8 * j; const LAS float* s = scr + (8 * c) * 33 + n;
        u32x4 o; o.x = cvt_pk_bf16(s[0 * 33] * scale, s[1 * 33] * scale); o.y = cvt_pk_bf16(s[2 * 33] * scale, s[3 * 33] * scale); o.z = cvt_pk_bf16(s[4 * 33] * scale, s[5 * 33] * scale); o.w = cvt_pk_bf16(s[6 * 33] * scale, s[7 * 33] * scale);
        *(u32x4*)(WT + (size_t)(dst_row0 + n) * dst_ld + k0 + 8 * c) = o; }
    LDS_WAIT(); asm volatile("" ::: "memory");
}

struct Ptrs {
    const float* x; const float* p; const float* w_in; const float* w_na; const float* w_gqa; const float* w_dil; const float* w_diff; const float* w_out;
    const float* rpb; const float* qk_gain; const float* lam; const float* diff_gain; const float* t5; const float* w_router;
    const float* w_eg; const float* w_eu; const float* w_ed; const float* w_pp; const float* w_pg; const float* ln_g; const float* ln_b;
    float* out; unsigned char* ws;
};

__device__ __forceinline__ void phase_convert(const Ptrs& P, int L, LAS unsigned char* lds, int gw, int NGW, int lane, int wave) {
    unsigned char* ws = P.ws;
    LAS float* scr = (LAS float*)(lds + wave * 16384);
    bf16_t* WIN = (bf16_t*)(ws + WS_WIN); bf16_t* WG = (bf16_t*)(ws + WS_WG);
    constexpr int J1 = 16 * 140, J2 = 16 * 128, J3 = 6 * 32, J4 = 6 * 32, J5 = 2 * 32, J6 = 8 * 32, J7 = 16 * 32, J8 = 16 * 32, J9 = 4 * 32;
    constexpr int NITEMS = J1 + J2 + J3 + J4 + J5 + J6 + J7 + J8 + J9;
    const float* w_in = P.w_in + (size_t)L * DM * INW;
    for (int it = gw; it < NITEMS; it += NGW) {
        int r = it;
        if (r < J1) { const int kb = r / 140, nb = r % 140, n0 = nb * 32; const bool isq = (n0 < 384) || (n0 >= C_QC && n0 < C_KC) || (n0 >= C_QD && n0 < C_KD);
            conv_item(w_in, INW, kb * 64, n0, WIN, DM, n0, isq ? QSCALE : 1.0f, scr, lane); continue; } r -= J1;
        if (r < J2) { const int kb = r / 128, nb = r % 128; conv_item(w_in, INW, kb * 64, C_HEND + nb * 32, WG, DM, nb * 32, 1.0f, scr, lane); continue; } r -= J2;
        if (r < J3) { const int kb = r / 32, nb = r % 32; conv_item(P.w_na + (size_t)L * 384 * DM, DM, kb * 64, nb * 32, (bf16_t*)(ws + WS_WNA), 384, nb * 32, 1.0f, scr, lane); continue; } r -= J3;
        if (r < J4) { const int kb = r / 32, nb = r % 32; conv_item(P.w_gqa + (size_t)L * 384 * DM, DM, kb * 64, nb * 32, (bf16_t*)(ws + WS_WGQA), 384, nb * 32, 1.0f, scr, lane); continue; } r -= J4;
        if (r < J5) { const int kb = r / 32, nb = r % 32; conv_item(P.w_dil + (size_t)L * 128 * DM, DM, kb * 64, nb * 32, (bf16_t*)(ws + WS_WDIL), 256, nb * 32, 1.0f, scr, lane); continue; } r -= J5;
        if (r < J6) { const int kb = r / 32, nb = r % 32; conv_item(P.w_diff + (size_t)L * 512 * DM, DM, kb * 64, nb * 32, (bf16_t*)(ws + WS_WDIFF), 512, nb * 32, 1.0f, scr, lane); continue; } r -= J6;
        if (r < J7) { const int kb = r / 32, nb = r % 32; conv_item(P.w_out + (size_t)L * DM * DM, DM, kb * 64, nb * 32, (bf16_t*)(ws + WS_WO), DM, nb * 32, 1.0f, scr, lane); continue; } r -= J7;
        if (r < J8) { const int kb = r / 32, nb = r % 32; conv_item(P.w_pg + (size_t)L * DM * DM, DM, kb * 64, nb * 32, (bf16_t*)(ws + WS_WPG), DM, nb * 32, 1.0f, scr, lane); continue; } r -= J8;
        if (r < J9) { const int kb = r / 32, nb = r % 32; conv_item(P.w_pp + (size_t)L * PLE * DM, DM, kb * 64, nb * 32, (bf16_t*)(ws + WS_WPP), PLE, nb * 32, 1.0f, scr, lane); continue; } r -= J9;
    }
    { const int gt = gw * 64 + lane, NT = NGW * 64;
      for (int i = gt; i < 1024 * 16; i += NT) { const int row = i >> 4, ch = i & 15; *(u32x4*)((bf16_t*)(ws + WS_WDIL) + (size_t)row * 256 + 128 + ch * 8) = (u32x4){0u, 0u, 0u, 0u}; }
      const f32x4* ps = (const f32x4*)(P.p + (size_t)L * MTOK * PLE); u32x2* pd = (u32x2*)(ws + WS_PB);
      static_assert((MTOK * PLE / 4) % (8 * 256 * 512) == 0 && (MTOK * DM / 4) % (8 * 256 * 512) == 0, "conversion loops are unrolled by 8 over a 256 x 512 grid");
      for (int i = gt; i < MTOK * PLE / 4; i += 8 * NT) { f32x4 v[8];
#pragma unroll
          for (int k = 0; k < 8; ++k) v[k] = __builtin_nontemporal_load(ps + i + k * NT);
          asm volatile("" ::: "memory");
#pragma unroll
          for (int k = 0; k < 8; ++k) { u32x2 o; o.x = cvt_pk_bf16(v[k][0], v[k][1]); o.y = cvt_pk_bf16(v[k][2], v[k][3]); pd[i + k * NT] = o; } }
      if (L == 0) { const f32x4* xs = (const f32x4*)P.x; u32x2* xd = (u32x2*)(ws + WS_XB);
          for (int i = gt; i < MTOK * DM / 4; i += 8 * NT) { f32x4 v[8];
#pragma unroll
              for (int k = 0; k < 8; ++k) v[k] = __builtin_nontemporal_load(xs + i + k * NT);
              asm volatile("" ::: "memory");
#pragma unroll
              for (int k = 0; k < 8; ++k) { u32x2 o; o.x = cvt_pk_bf16(v[k][0], v[k][1]); o.y = cvt_pk_bf16(v[k][2], v[k][3]); xd[i + k * NT] = o; } } }
    }
}

__device__ __forceinline__ void phase_qknorm(const Ptrs& P, int L, int gw, int NGW, int lane) {
    bf16_t* H = (bf16_t*)(P.ws + WS_H);
    const int head = lane >> 3, j = lane & 7;
    const float* gain = P.qk_gain + (size_t)L * 128 + (head < 6 ? 0 : 64) + j * 8;
    float g[8];
#pragma unroll
    for (int e = 0; e < 8; ++e) g[e] = gain[e];
    float fr[8];
#pragma unroll
    for (int e = 0; e < 8; ++e) fr[e] = __builtin_amdgcn_exp2f(-(float)((j & 1) * 8 + e) * (13.287712379549449f / 16.0f));
    const float osc = head < 6 ? QSCALE : 1.0f;
    for (int m0 = gw; m0 < MTOK; m0 += 4 * NGW) {
        u32x4 raw[4];
#pragma unroll
        for (int k = 0; k < 4; ++k) raw[k] = *(const u32x4*)(H + (size_t)(m0 + k * NGW) * HW + C_QB + lane * 8);
        asm volatile("" ::: "memory");
#pragma unroll
        for (int k = 0; k < 4; ++k) {
            const int m = m0 + k * NGW;
            bf16_t* hp = H + (size_t)m * HW + C_QB + lane * 8;
            const u32x4 w = raw[k];
            float v[8] = {bf_lo(w.x), bf_hi(w.x), bf_lo(w.y), bf_hi(w.y), bf_lo(w.z), bf_hi(w.z), bf_lo(w.w), bf_hi(w.w)};
            float ss = 0.f;
#pragma unroll
            for (int e = 0; e < 8; ++e) ss += v[e] * v[e];
            ss += __shfl_xor(ss, 1); ss += __shfl_xor(ss, 2); ss += __shfl_xor(ss, 4);
            const float rs = rsqrtf(ss * (1.0f / 64.0f) + 1e-6f);
            const int tpos = m & (SEQ - 1); const float pos = (float)((j < 4) ? (tpos >> 6) : (tpos & 63));
            float o[8];
#pragma unroll
            for (int e = 0; e < 8; ++e) {
                const float y = v[e] * rs * g[e];
                const float yo = __shfl_xor(y, 2);
                float rev = pos * fr[e] * 0.15915494309189535f; rev -= floorf(rev);
                const float sn = __builtin_amdgcn_sinf(rev), cs = __builtin_amdgcn_cosf(rev);
                o[e] = ((j & 2) == 0) ? (y * cs - yo * sn) : (y * cs + yo * sn);
                o[e] *= osc;
            }
            u32x4 ow; ow.x = cvt_pk_bf16(o[0], o[1]); ow.y = cvt_pk_bf16(o[2], o[3]); ow.z = cvt_pk_bf16(o[4], o[5]); ow.w = cvt_pk_bf16(o[6], o[7]);
            *(u32x4*)hp = ow;
        }
    }
}

__device__ __forceinline__ void ln_row(f32x4 (&v)[4], const float* g, const float* b, int lane) {
    float s = 0.f;
#pragma unroll
    for (int j = 0; j < 4; ++j) s += (v[j][0] + v[j][1]) + (v[j][2] + v[j][3]);
    const float mean = wave_sum(s) * (1.0f / DM); float s2 = 0.f;
#pragma unroll
    for (int j = 0; j < 4; ++j) { v[j] = v[j] - mean; s2 += (v[j][0] * v[j][0] + v[j][1] * v[j][1]) + (v[j][2] * v[j][2] + v[j][3] * v[j][3]); }
    const float rstd = rsqrtf(wave_sum(s2) * (1.0f / DM) + LN_EPS);
#pragma unroll
    for (int j = 0; j < 4; ++j) { const f32x4 gg = *(const f32x4*)(g + 256 * j + 4 * lane), bb = *(const f32x4*)(b + 256 * j + 4 * lane); v[j] = v[j] * rstd * gg + bb; }
}
__device__ __forceinline__ void load_row_bf16(f32x4 (&v)[4], const bf16_t* zr, int lane, float scale) {
#pragma unroll
    for (int j = 0; j < 4; ++j) { const u32x2 w = *(const u32x2*)(zr + 256 * j + 4 * lane); v[j] = (f32x4){bf_lo(w.x) * scale, bf_hi(w.x) * scale, bf_lo(w.y) * scale, bf_hi(w.y) * scale}; }
}
__device__ __forceinline__ void store_row_bf16(const f32x4 (&v)[4], bf16_t* xb, int lane) {
#pragma unroll
    for (int j = 0; j < 4; ++j) { u32x2 o; o.x = cvt_pk_bf16(v[j][0], v[j][1]); o.y = cvt_pk_bf16(v[j][2], v[j][3]); *(u32x2*)(xb + 256 * j + 4 * lane) = o; }
}
__device__ __forceinline__ void store_row_f32(const f32x4 (&v)[4], float* xo, int lane) {
#pragma unroll
    for (int j = 0; j < 4; ++j) __builtin_nontemporal_store(v[j], (f32x4*)(xo + 256 * j + 4 * lane));
}

__device__ __forceinline__ void phase_ln1_router(const Ptrs& P, int L, const bf16_t* Z, LAS unsigned char* lds, int gw, int NGW, int lane, int tid) {
    LAS float* wT = (LAS float*)lds;
    const float* wr = P.w_router + (size_t)L * DM * NEXP;
    { f32x4 wv[8];
#pragma unroll
      for (int q = 0; q < 8; ++q) wv[q] = ((const f32x4*)wr)[tid + 512 * q];
      asm volatile("" ::: "memory");
#pragma unroll
      for (int q = 0; q < 8; ++q) { const int i = 4 * (tid + 512 * q), k = i >> 4, e0 = i & 15;
#pragma unroll
          for (int c = 0; c < 4; ++c) wT[(e0 + c) * DM + k] = wv[q][c]; } }
    __syncthreads();
    bf16_t* XB = (bf16_t*)(P.ws + WS_XB); float* AFF = (float*)(P.ws + WS_AFF);
    const float* g = P.ln_g + (size_t)(L * 3 + 0) * DM; const float* b = P.ln_b + (size_t)(L * 3 + 0) * DM;
    for (int m0 = gw; m0 < MTOK; m0 += 4 * NGW) {
      u32x2 raw[4][4];
#pragma unroll
      for (int k = 0; k < 4; ++k)
#pragma unroll
          for (int j = 0; j < 4; ++j) raw[k][j] = *(const u32x2*)(Z + (size_t)(m0 + k * NGW) * DM + 256 * j + 4 * lane);
      asm volatile("" ::: "memory");
#pragma unroll
      for (int k = 0; k < 4; ++k) {
        const int m = m0 + k * NGW;
        f32x4 v[4];
#pragma unroll
        for (int j = 0; j < 4; ++j) v[j] = (f32x4){bf_lo(raw[k][j].x), bf_hi(raw[k][j].x), bf_lo(raw[k][j].y), bf_hi(raw[k][j].y)};
        ln_row(v, g, b, lane);
        store_row_bf16(v, XB + (size_t)m * DM, lane);
        float a16[16];
        const LAS float* wl = wT + 4 * lane; asm volatile("" : "+v"(wl));
#pragma unroll
        for (int e = 0; e < 16; ++e) { float a = 0.f;
#pragma unroll
            for (int j = 0; j < 4; ++j) { const f32x4 w = *(const LAS f32x4*)(wl + e * DM + 256 * j); a += (v[j][0] * w[0] + v[j][1] * w[1]) + (v[j][2] * w[2] + v[j][3] * w[3]); }
            a16[e] = a; }
        float a8[8], a4[4], a2[2], a1;
#pragma unroll
        for (int i = 0; i < 8; ++i) { const bool up = (lane & 32) != 0; const float send = up ? a16[i] : a16[8 + i], keep = up ? a16[8 + i] : a16[i]; a8[i] = keep + __shfl_xor(send, 32); }
#pragma unroll
        for (int i = 0; i < 4; ++i) { const bool up = (lane & 16) != 0; const float send = up ? a8[i] : a8[4 + i], keep = up ? a8[4 + i] : a8[i]; a4[i] = keep + __shfl_xor(send, 16); }
#pragma unroll
        for (int i = 0; i < 2; ++i) { const bool up = (lane & 8) != 0; const float send = up ? a4[i] : a4[2 + i], keep = up ? a4[2 + i] : a4[i]; a2[i] = keep + __shfl_xor(send, 8); }
        { const bool up = (lane & 4) != 0; const float send = up ? a2[0] : a2[1], keep = up ? a2[1] : a2[0]; a1 = keep + __shfl_xor(send, 4); }
        a1 += __shfl_xor(a1, 2); a1 += __shfl_xor(a1, 1);
        float mx = a1;
        mx = fmaxf(mx, __shfl_xor(mx, 4)); mx = fmaxf(mx, __shfl_xor(mx, 8)); mx = fmaxf(mx, __shfl_xor(mx, 16)); mx = fmaxf(mx, __shfl_xor(mx, 32));
        const float ex_ = __expf(a1 - mx);
        float den = ex_;
        den += __shfl_xor(den, 4); den += __shfl_xor(den, 8); den += __shfl_xor(den, 16); den += __shfl_xor(den, 32);
        const int myexp = 8 * (lane >> 5) + 4 * ((lane >> 4) & 1) + 2 * ((lane >> 3) & 1) + ((lane >> 2) & 1);
        const float mine = ex_; const int lane_e = myexp;
        if ((lane & 3) == 0) AFF[((size_t)(m >> 13) * NEXP + lane_e) * SEQ + (m & (SEQ - 1))] = mine / den;
      }
    }
}

__device__ __forceinline__ void phase_topk(const Ptrs& P, LAS unsigned char* lds, int blk, int G, int tid, int lane, int wave) {
    LAS unsigned* hist = (LAS unsigned*)lds;
    LAS unsigned* ctl = hist + 256;
    LAS unsigned* wtot = hist + 320;
    const float* AFF = (const float*)(P.ws + WS_AFF); int* SLOT = (int*)(P.ws + WS_SLOT); int* IDX = (int*)(P.ws + WS_IDX); float* GATEV = (float*)(P.ws + WS_GATEV);
    LAS int* lst = (LAS int*)(hist + 384);
    const bf16_t* XB = (const bf16_t*)(P.ws + WS_XB); bf16_t* XIN = (bf16_t*)(P.ws + WS_XIN);
    for (int it4 = blk; it4 < 4 * NB * NEXP; it4 += G) {
        const int item = it4 >> 2, part = it4 & 3;
        const int b = item >> 4, e = item & 15;
        const u32x4* src = (const u32x4*)(AFF + (size_t)item * SEQ) + tid * 4;
        unsigned key[16];
#pragma unroll
        for (int j = 0; j < 4; ++j) { const u32x4 w = src[j]; key[4 * j] = w.x; key[4 * j + 1] = w.y; key[4 * j + 2] = w.z; key[4 * j + 3] = w.w; }
        unsigned prefix = 0u, mask = 0u, need = CAP;
#pragma unroll 1
        for (int pass = 0; pass < 4; ++pass) {
            const int shift = 24 - 8 * pass;
            if (tid < 256) hist[tid] = 0u;
            __syncthreads();
#pragma unroll
            for (int j = 0; j < 16; ++j) if ((key[j] & mask) == prefix) __hip_atomic_fetch_add(&hist[(key[j] >> shift) & 255u], 1u, __ATOMIC_RELAXED, __HIP_MEMORY_SCOPE_WORKGROUP);
            __syncthreads();
            if (wave == 0) {
                unsigned c[4]; unsigned s = 0u;
#pragma unroll
                for (int j = 0; j < 4; ++j) { c[j] = hist[255 - (4 * lane + j)]; s += c[j]; }
                unsigned incl = s;
#pragma unroll
                for (int o = 1; o < 64; o <<= 1) { const unsigned t = __shfl_up(incl, o); if (lane >= o) incl += t; }
                const unsigned excl = incl - s;
                if (excl < need && need <= incl) {
                    unsigned run = excl; unsigned bin = 0u, nn = 0u; bool found = false;
#pragma unroll
                    for (int j = 0; j < 4; ++j) { if (!found && run + c[j] >= need) { bin = 255u - (unsigned)(4 * lane + j); nn = need - run; found = true; } run += c[j]; }
                    ctl[0] = bin; ctl[1] = nn;
                }
            }
            __syncthreads();
            prefix |= ctl[0] << shift; mask |= 0xFFu << shift; need = ctl[1];
            __syncthreads();
        }
        unsigned gt = 0u, eq = 0u;
#pragma unroll
        for (int j = 0; j < 16; ++j) { gt += key[j] > prefix ? 1u : 0u; eq += key[j] == prefix ? 1u : 0u; }
        const unsigned mine = gt | (eq << 16);
        unsigned incl = mine;
#pragma unroll
        for (int o = 1; o < 64; o <<= 1) { const unsigned t = __shfl_up(incl, o); if (lane >= o) incl += t; }
        if (lane == 63) wtot[wave] = incl;
        __syncthreads();
        unsigned base = 0u;
#pragma unroll
        for (int w = 0; w < 8; ++w) base += (w < wave) ? wtot[w] : 0u;
        unsigned run = base + incl - mine;
        unsigned gtb = run & 0xffffu, eqb = run >> 16;
        int* slot = SLOT + ((size_t)b * SEQ) * NEXP + e;
#pragma unroll
        for (int j = 0; j < 16; ++j) {
            const int s = tid * 16 + j; const unsigned k = key[j];
            const bool isgt = k > prefix, iseq = k == prefix;
            const bool sel = isgt || (iseq && eqb < need);
            const unsigned pos = gtb + (eqb < need ? eqb : need);
            if (sel && (int)(pos >> 8) == part) { IDX[(size_t)(e * NB + b) * CAP + pos] = b * SEQ + s; GATEV[(size_t)(e * NB + b) * CAP + pos] = __uint_as_float(k); }
            if ((tid >> 7) == part) slot[(size_t)s * NEXP] = sel ? (int)pos : -1;
            gtb += isgt ? 1u : 0u; eqb += iseq ? 1u : 0u;
        }
        __syncthreads();
        __syncthreads();
    }
}

__device__ __forceinline__ void phase_gather(const Ptrs& P, int gw, int NGW, int lane) {
    const bf16_t* XB = (const bf16_t*)(P.ws + WS_XB); bf16_t* XIN = (bf16_t*)(P.ws + WS_XIN); const int* IDX = (const int*)(P.ws + WS_IDX);
    for (int r0 = gw; r0 < NB * NEXP * CAP; r0 += 4 * NGW) {
        int sidx[4];
#pragma unroll
        for (int k = 0; k < 4; ++k) { const int r = r0 + k * NGW; const int c = r & (CAP - 1), eb = r >> 10, b = eb & 3, e = eb >> 2; sidx[k] = b * SEQ + IDX[(b * NEXP + e) * CAP + c]; }
        u32x4 v0[4], v1[4];
#pragma unroll
        for (int k = 0; k < 4; ++k) { const u32x4* src = (const u32x4*)(XB + (size_t)sidx[k] * DM); v0[k] = src[lane]; v1[k] = src[64 + lane]; }
        asm volatile("" ::: "memory");
#pragma unroll
        for (int k = 0; k < 4; ++k) { u32x4* dst = (u32x4*)(XIN + (size_t)(r0 + k * NGW) * DM); dst[lane] = v0[k]; dst[64 + lane] = v1[k]; }
    }
}

__device__ __forceinline__ void phase_ln2(const Ptrs& P, int L, int gw, int NGW, int lane) {
    const bf16_t* YO = (const bf16_t*)(P.ws + WS_XIN); const int* SLOT = (const int*)(P.ws + WS_SLOT); bf16_t* XB = (bf16_t*)(P.ws + WS_XB);
    const float* g = P.ln_g + (size_t)(L * 3 + 1) * DM; const float* bb = P.ln_b + (size_t)(L * 3 + 1) * DM;
    for (int m0 = gw; m0 < MTOK; m0 += 2 * NGW) {
        const int m1 = m0 + NGW;
        f32x4 v0[4], v1[4]; load_row_bf16(v0, XB + (size_t)m0 * DM, lane, ALPHA); load_row_bf16(v1, XB + (size_t)m1 * DM, lane, ALPHA);
        const int s0 = SLOT[(size_t)m0 * NEXP + (lane & 15)], s1 = SLOT[(size_t)m1 * NEXP + (lane & 15)];
        unsigned bm = (unsigned)(__ballot(s0 >= 0) & 0xffffull) | ((unsigned)(__ballot(s1 >= 0) & 0xffffull) << 16);
        const int sl = (lane & 16) ? s1 : s0;
        while (bm) {
            int id[4]; bool ok[4]; u32x2 w[4][4];
#pragma unroll
            for (int q = 0; q < 4; ++q) { ok[q] = bm != 0u; id[q] = ok[q] ? __builtin_ctz(bm) : 0; bm = ok[q] ? (bm & (bm - 1u)) : 0u; }
#pragma unroll
            for (int q = 0; q < 4; ++q) if (ok[q]) {
                const int c = __shfl(sl, id[q]), e = id[q] & 15, b = ((id[q] >> 4) ? m1 : m0) >> 13;
                const bf16_t* yr = YO + (size_t)((e * NB + b) * CAP + c) * DM;
#pragma unroll
                for (int j = 0; j < 4; ++j) w[q][j] = *(const u32x2*)(yr + 256 * j + 4 * lane); }
#pragma unroll
            for (int q = 0; q < 4; ++q) if (ok[q]) {
                if (id[q] >> 4) {
#pragma unroll
                    for (int j = 0; j < 4; ++j) { v1[j][0] += bf_lo(w[q][j].x); v1[j][1] += bf_hi(w[q][j].x); v1[j][2] += bf_lo(w[q][j].y); v1[j][3] += bf_hi(w[q][j].y); }
                } else {
#pragma unroll
                    for (int j = 0; j < 4; ++j) { v0[j][0] += bf_lo(w[q][j].x); v0[j][1] += bf_hi(w[q][j].x); v0[j][2] += bf_lo(w[q][j].y); v0[j][3] += bf_hi(w[q][j].y); }
                } }
        }
        ln_row(v0, g, bb, lane); store_row_bf16(v0, XB + (size_t)m0 * DM, lane);
        ln_row(v1, g, bb, lane); store_row_bf16(v1, XB + (size_t)m1 * DM, lane);
    }
}

__device__ __forceinline__ void phase_ln3(const Ptrs& P, int L, const bf16_t* Z, float* XO, int gw, int NGW, int lane) {
    bf16_t* XB = (bf16_t*)(P.ws + WS_XB);
    const float* g = P.ln_g + (size_t)(L * 3 + 2) * DM; const float* bb = P.ln_b + (size_t)(L * 3 + 2) * DM;
    for (int m0 = gw; m0 < MTOK; m0 += 4 * NGW) {
        u32x2 raw[4][4];
#pragma unroll
        for (int k = 0; k < 4; ++k)
#pragma unroll
            for (int j = 0; j < 4; ++j) raw[k][j] = *(const u32x2*)(Z + (size_t)(m0 + k * NGW) * DM + 256 * j + 4 * lane);
        asm volatile("" ::: "memory");
#pragma unroll
        for (int k = 0; k < 4; ++k) {
            const int m = m0 + k * NGW;
            f32x4 v[4];
#pragma unroll
            for (int j = 0; j < 4; ++j) v[j] = (f32x4){bf_lo(raw[k][j].x), bf_hi(raw[k][j].x), bf_lo(raw[k][j].y), bf_hi(raw[k][j].y)};
            ln_row(v, g, bb, lane);
            if (L == DEPTH - 1) store_row_f32(v, XO + (size_t)m * DM, lane); else store_row_bf16(v, XB + (size_t)m * DM, lane);
        }
    }
}

constexpr int NPH = 14;
struct Args { Ptrs P; int ph_lo, ph_hi, li, pad; };
__global__ void __launch_bounds__(512, 2) mega_fwd(Args args) {
    extern __shared__ __attribute__((aligned(16))) unsigned char lds_raw[];
    LAS unsigned char* lds = (LAS unsigned char*)lds_raw;
    const int tid0 = threadIdx.x;
    const int G = gridDim.x, bx0 = blockIdx.x, NGW = G * 8;
    volatile LAS unsigned* MISC = (volatile LAS unsigned*)(lds + MISC_OFF);
    for (int u = tid0; u < 32; u += 512) MISC[u] = 0u;
#define LAYER_PTRS const bf16_t* xprev = (const bf16_t*)(ws + WS_XB); bf16_t* Za = (bf16_t*)(ws + WS_Z1); bf16_t* Zb = (bf16_t*)(ws + WS_XB); bf16_t* Zc = Za; \
    float* Xo = P.out; const char* XBc = (const char*)(ws + WS_XB); (void)xprev; (void)Zb; (void)Zc; (void)Xo; (void)XBc; (void)Za;
#define PHASE_IDS const __attribute__((address_space(4))) Ptrs* Pp_ = (const __attribute__((address_space(4))) Ptrs*)__builtin_amdgcn_kernarg_segment_ptr(); asm volatile("" : "+s"(Pp_)); Ptrs P; P.x = Pp_->x; P.p = Pp_->p; P.w_in = Pp_->w_in; P.w_na = Pp_->w_na; P.w_gqa = Pp_->w_gqa; P.w_dil = Pp_->w_dil; P.w_diff = Pp_->w_diff; P.w_out = Pp_->w_out; P.rpb = Pp_->rpb; P.qk_gain = Pp_->qk_gain; P.lam = Pp_->lam; P.diff_gain = Pp_->diff_gain; P.t5 = Pp_->t5; P.w_router = Pp_->w_router; P.w_eg = Pp_->w_eg; P.w_eu = Pp_->w_eu; P.w_ed = Pp_->w_ed; P.w_pp = Pp_->w_pp; P.w_pg = Pp_->w_pg; P.ln_g = Pp_->ln_g; P.ln_b = Pp_->ln_b; P.out = Pp_->out; P.ws = Pp_->ws; unsigned char* ws = P.ws; (void)ws; int tid = tid0; asm volatile("" : "+v"(tid)); int bx = bx0; asm volatile("" : "+s"(bx)); \
    const int lane = tid & 63, wave = __builtin_amdgcn_readfirstlane(tid >> 6); const int vcu = (bx & 7) * (G >> 3) + (bx >> 3); const int gw = vcu * 8 + wave; (void)lane; (void)gw; (void)vcu; LAYER_PTRS
    __syncthreads();
    XcdBarrier bar = xcd_barrier_post((unsigned*)(args.P.ws + WS_CTL) + CW_BAR + args.li * XCD_BAR_WORDS, MISC + 8);
    const int lo = args.ph_lo, hi = args.ph_hi;
#ifndef PHMASK
#define PHMASK 0x3fff
#endif
#ifndef ATT_MASK
#define ATT_MASK 31
#endif
#define IN(k) (((PHMASK >> ((k) % NPH)) & 1) && lo <= (k) && (k) < hi)
#define SEAM(k) do { if (IN(k) && IN((k) + 1)) xcd_barrier(bar); } while (0)

#define ATT_GRP(g_) do { const unsigned simd_ = (unsigned)__builtin_amdgcn_s_getreg((1 << 11) | (4 << 6) | 4); \
        if (lane == 0) MISC[16 + wave] = simd_; \
        __syncthreads(); \
        int rank_ = 0; \
        _Pragma("unroll") for (int w = 0; w < 8; ++w) rank_ += (w < wave && MISC[16 + w] == simd_) ? 1 : 0; \
        g_ = __builtin_amdgcn_readfirstlane(rank_ & 1); __syncthreads(); } while (0)
    for (int L = 0; L < DEPTH; ++L) {
        const int pb = L * NPH;
        if (L == 0) { if (IN(pb + 0)) { PHASE_IDS phase_convert(P, L, lds, gw, NGW, lane, wave); }
            SEAM(pb + 0); }
        if (IN(pb + 1)) { PHASE_IDS
            pg8::SchedInProj S{XBc, (const char*)(ws + WS_WIN), G, bx};
            pg8::EpiInProj E{(bf16_t*)(ws + WS_H), (bf16_t*)(ws + WS_S)};
            pg8::gemm_phase<pg8::EpiInProj, pg8::SchedInProj>(lds, S, E, tid);
        }
        SEAM(pb + 1);
        if (IN(pb + 2)) { PHASE_IDS phase_qknorm(P, L, gw, NGW, lane);
            const bf16_t* H = (const bf16_t*)(ws + WS_H);
            LAS char* shm = (LAS char*)lds;
            int grp; ATT_GRP(grp);
            if (ATT_MASK & 8) { for (int u = vcu; u < 256; u += G) att::unit_dil_part<1>(shm, H, (bf16_t*)(ws + WS_YC), (float*)(ws + WS_AFF), P.t5, u, tid, grp);
                                for (int u = vcu; u < 256; u += G) att::unit_dil_part<2>(shm, H, (bf16_t*)(ws + WS_YC), (float*)(ws + WS_AFF), P.t5, u, tid, grp); }
        }
        SEAM(pb + 2);
        if (IN(pb + 3)) { PHASE_IDS
            const bf16_t* H = (const bf16_t*)(ws + WS_H);
            LAS char* shm = (LAS char*)lds;
            const float lam_init = (L == 0) ? 0.2f : 0.35550906759096926f;
            float* stash = (float*)(ws + WS_MERGED) + (size_t)bx * 65536;
            int grp; ATT_GRP(grp);
            if (ATT_MASK & 1) { int j = 0; for (int u = vcu; u < 512; u += G, ++j) att::unit_diff<0>(shm, H, (bf16_t*)(ws + WS_YD), P.t5, P.lam + (size_t)L * 256, P.diff_gain + (size_t)L * 128, lam_init, stash + (size_t)(j & 1) * 32768, u, tid, wave, lane, grp); }
            if (ATT_MASK & 16) { int j = 0; for (int u = vcu; u < 512; u += G, ++j) att::unit_diff<1>(shm, H, (bf16_t*)(ws + WS_YD), P.t5, P.lam + (size_t)L * 256, P.diff_gain + (size_t)L * 128, lam_init, stash + (size_t)(j & 1) * 32768, u, tid, wave, lane, grp); }
            if (ATT_MASK & 2) { int j = 0; for (int u = vcu; u < 768; u += G, ++j) { const att::SideConv side{P.w_eg + (size_t)L * NEXP * DM * FF, P.w_eu + (size_t)L * NEXP * DM * FF, P.w_ed + (size_t)L * NEXP * FF * DM, ws, vcu * 96 + j * 32};
                att::unit_gqa(shm, H, (bf16_t*)(ws + WS_YB), u, tid, wave, lane, grp, side); } }
            if (ATT_MASK & 4) for (int u = vcu; u < 768; u += G) att::unit_na(shm, H, (bf16_t*)(ws + WS_YA), P.rpb + (size_t)L * 6 * 465, u, tid, wave, lane, grp);
            if (ATT_MASK & 8) for (int u = vcu; u < 256; u += G) att::unit_dil(shm, H, (bf16_t*)(ws + WS_YC), (const float*)(ws + WS_AFF), P.t5, u, tid, wave, lane, grp);
        }
        SEAM(pb + 3);
        if (IN(pb + 4)) { PHASE_IDS
            pg8::SchedMerge S{(const char*)ws, G, bx};
            pg8::EpiGateAcc E{(const bf16_t*)(ws + WS_S), (bf16_t*)(ws + WS_MERGED)};
            pg8::gemm_phase<pg8::EpiGateAcc, pg8::SchedMerge>(lds, S, E, tid);
        }
        SEAM(pb + 4);
        if (IN(pb + 5)) { PHASE_IDS
            pg8::SchedPlain S{(const char*)(ws + WS_MERGED), (const char*)(ws + WS_WO), 2048, 16, 128, 4, G, bx, 0};
            pg8::EpiResid E{xprev, Za};
            pg8::gemm_phase<pg8::EpiResid, pg8::SchedPlain>(lds, S, E, tid);
        }
        SEAM(pb + 5);
        if (IN(pb + 6)) { PHASE_IDS phase_ln1_router(P, L, Za, lds, gw, NGW, lane, tid); }
        SEAM(pb + 6);
        if (IN(pb + 7)) { PHASE_IDS phase_topk(P, lds, bx, G, tid, lane, wave); }
        SEAM(pb + 7);
        if (IN(pb + 9)) { PHASE_IDS
            pg8::SchedFfnUp S{XBc, (const char*)(ws + WS_WGU), (const int*)(ws + WS_IDX), G, bx};
            pg8::EpiSwiGLU E{(bf16_t*)(ws + WS_HID)};
            pg8::gemm_phase<pg8::EpiSwiGLU, pg8::SchedFfnUp>(lds, S, E, tid);
        }
        SEAM(pb + 9);
        if (IN(pb + 10)) { PHASE_IDS
            pg8::SchedFfnDown S{(const char*)(ws + WS_HID), (const char*)(ws + WS_WD), G, bx};
            pg8::EpiRowScale E{(bf16_t*)(ws + WS_XIN), (const float*)(ws + WS_GATEV)};
            pg8::gemm_phase<pg8::EpiRowScale, pg8::SchedFfnDown>(lds, S, E, tid);
        }
        SEAM(pb + 10);
        if (IN(pb + 11)) { PHASE_IDS phase_ln2(P, L, gw, NGW, lane); }
        SEAM(pb + 11);
        if (IN(pb + 12)) { PHASE_IDS
            pg8::SchedPle S{XBc, (const char*)(ws + WS_WPG), (const char*)(ws + WS_PB), (const char*)(ws + WS_WPP), G, bx};
            pg8::EpiPle E{(bf16_t*)(ws + WS_MERGED), Zb, Zc};
            pg8::gemm_phase<pg8::EpiPle, pg8::SchedPle>(lds, S, E, tid);
        }
        SEAM(pb + 12);
        if (IN(pb + 13)) { PHASE_IDS phase_ln3(P, L, Zc, Xo, gw, NGW, lane); if (L + 1 < DEPTH) phase_convert(P, L + 1, lds, gw, NGW, lane, wave); }
        SEAM(pb + 13);
    }
#undef IN
#undef SEAM
}


#ifdef DBG_STOP
__global__ void dbg_dump(const unsigned char* ws, float* out, int mode) {
    const size_t i = (size_t)blockIdx.x * blockDim.x + threadIdx.x;
    if (i >= (size_t)MTOK * DM) return;
    const int m = (int)(i >> 10), c = (int)(i & 1023);
    float v = 0.f;
    auto bf = [](const unsigned char* base, size_t idx) { return __uint_as_float(((unsigned)((const bf16_t*)base)[idx]) << 16); };
    if (mode <= 2) { for (int j = 0; j < 4; ++j) v += bf(ws + WS_H, (size_t)m * HW + c + 1024 * j); if (c < 384) v += bf(ws + WS_H, (size_t)m * HW + 4096 + c); }
    else if (mode == 3) { if (c < 384) v += bf(ws + WS_YA, (size_t)m * 384 + c) + 2.f * bf(ws + WS_YB, (size_t)m * 384 + c); if (c < 256) v += 3.f * bf(ws + WS_YC, (size_t)m * 256 + c); if (c < 512) v += 4.f * bf(ws + WS_YD, (size_t)m * 512 + c); }
    else if (mode == 4) v = bf(ws + WS_MERGED, (size_t)m * DM + c);
    else if (mode == 5 || mode == 6 || mode == 12) v = ((const float*)(ws + WS_Z1))[i];
    else if (mode == 7) v = c < 16 ? (float)((const int*)(ws + WS_SLOT))[(size_t)m * 16 + c] : (c < 32 ? ((const float*)(ws + WS_AFF))[(size_t)((m >> 13) * 16 + (c - 16)) * SEQ + (m & 8191)] : 0.f);
    else if (mode == 8) v = bf(ws + WS_XIN, (size_t)m * DM + c) + bf(ws + WS_XIN, (size_t)(m + 32768) * DM + c);
    else if (mode == 9) { for (int j = 0; j < 2; ++j) v += bf(ws + WS_HID, (size_t)m * FF + c + 1024 * j) + bf(ws + WS_HID, (size_t)(m + 32768) * FF + c + 1024 * j); }
    else if (mode == 10) v = bf(ws + WS_XIN, (size_t)m * DM + c) + bf(ws + WS_XIN, (size_t)(m + 32768) * DM + c);
    else if (mode == 11) v = ((const float*)(ws + WS_Z2))[i];
    else v = ((const float*)(ws + WS_Z1))[i];
    out[i] = v;
}
#endif
extern "C" void kernel_launch(void* const* d_in, const int* in_sizes, int n_in, void* d_out, int out_size, void* d_ws, size_t ws_size, hipStream_t stream) {
    static int grid = 0;
    if (grid == 0) {
        if (n_in != 21 || out_size != MTOK * DM || ws_size < WS_END) { fprintf(stderr, "kernel_launch: unexpected shapes (n_in %d out %d ws %zu need %zu)\n", n_in, out_size, ws_size, (size_t)WS_END); grid = -1; return; }
        int dev = 0, cus = 0;
        if (hipGetDevice(&dev) != hipSuccess || hipDeviceGetAttribute(&cus, hipDeviceAttributeMultiprocessorCount, dev) != hipSuccess) { grid = -1; return; }
        if (hipFuncSetAttribute((const void*)mega_fwd, hipFuncAttributeMaxDynamicSharedMemorySize, LDS_BYTES) != hipSuccess) { fprintf(stderr, "kernel_launch: hipFuncSetAttribute failed\n"); grid = -1; return; }
        int per_cu = 0;
        if (hipOccupancyMaxActiveBlocksPerMultiprocessor(&per_cu, (const void*)mega_fwd, 512, LDS_BYTES) != hipSuccess || per_cu < 1) fprintf(stderr, "kernel_launch: occupancy query reports %d\n", per_cu);
        (void)hipGetLastError();
        grid = 256;
        if (cus != 256) fprintf(stderr, "kernel_launch: %d CUs reported; this kernel is built for 256\n", cus);
    }
    if (grid < 0) return;
    (void)hipMemsetAsync((char*)d_ws + WS_CTL, 0, CTL_ZERO_BYTES, stream);
    Args a{};
    const float* const* in = (const float* const*)d_in;
    a.P.x = in[0]; a.P.p = in[1]; a.P.w_in = in[2]; a.P.w_na = in[3]; a.P.w_gqa = in[4]; a.P.w_dil = in[5]; a.P.w_diff = in[6]; a.P.w_out = in[7];
    a.P.rpb = in[8]; a.P.qk_gain = in[9]; a.P.lam = in[10]; a.P.diff_gain = in[11]; a.P.t5 = in[12]; a.P.w_router = in[13];
    a.P.w_eg = in[14]; a.P.w_eu = in[15]; a.P.w_ed = in[16]; a.P.w_pp = in[17]; a.P.w_pg = in[18]; a.P.ln_g = in[19]; a.P.ln_b = in[20];
    a.P.out = (float*)d_out; a.P.ws = (unsigned char*)d_ws;
#ifdef DBG_STOP
    for (int li = 0; li <= DBG_STOP; ++li) { a.ph_lo = li; a.ph_hi = li + 1; hipLaunchKernelGGL(mega_fwd, dim3(grid), dim3(512), LDS_BYTES, stream, a); }
    hipLaunchKernelGGL(dbg_dump, dim3(MTOK * DM / 256), dim3(256), 0, stream, (const unsigned char*)d_ws, (float*)d_out, (int)DBG_STOP);
#else
#ifdef DUP_MASK
    { int li = 0;
      for (int ph = 0; ph < DEPTH * NPH; ++ph) { const int reps = ((DUP_MASK >> (ph % NPH)) & 1) ? 2 : 1;
          for (int r = 0; r < reps; ++r) { a.li = (li++) % 8; a.ph_lo = ph; a.ph_hi = ph + 1; hipLaunchKernelGGL(mega_fwd, dim3(grid), dim3(512), LDS_BYTES, stream, a); } } }
#else
#ifndef N_SPLIT
#define N_SPLIT 1
#endif
    for (int li = 0; li < N_SPLIT; ++li) {
        a.li = li % 8; a.ph_lo = li * (DEPTH * NPH) / N_SPLIT; a.ph_hi = (li + 1) * (DEPTH * NPH) / N_SPLIT;
        hipLaunchKernelGGL(mega_fwd, dim3(grid), dim3(512), LDS_BYTES, stream, a);
    }
#endif
#endif
}
```
